# Optimizing an MI355X kernel written in HIP

```python
import math
import jax, jax.numpy as jnp
from jax import lax
import numpy as np

D_MODEL = 1024
BATCH = 4
SEQ = 8192
DEPTH = 1

MIX_WIDTH = D_MODEL
GLA_WIDTH = MIX_WIDTH // 2
GLA_HEADS = 4
GLA_DV = GLA_WIDTH // GLA_HEADS
GLA_DK = GLA_DV // 2
GLA_GATE_RANK = 16
GLA_GATE_NORMALIZER = 16.0
GLA_CHUNK = 64
SB_WIDTH = MIX_WIDTH - GLA_WIDTH
SB_HEAD_DIM = 64
SB_HEADS = SB_WIDTH // SB_HEAD_DIM
SB_BLOCK = 128
MEM_LEN = 256
MEM_HEADS = 4
MEM_HEAD_DIM = D_MODEL // MEM_HEADS
D_FF = -(-8 * D_MODEL // (3 * 256)) * 256
RMS_EPS = 1e-6
GLA_QK_W = GLA_HEADS * GLA_DK
GLA_V_W = GLA_HEADS * GLA_DV
IN_SIZES = (GLA_QK_W, GLA_QK_W, GLA_V_W, GLA_V_W, GLA_GATE_RANK, SB_WIDTH, SB_WIDTH, SB_WIDTH)
D_IN = sum(IN_SIZES)

kernel_name = "hybrid_gla_stickbreaking_memxattn_swiglu"


def rms_norm(x, w):
    xf = x.astype(jnp.float32)
    y = xf * lax.rsqrt(jnp.mean(xf * xf, axis=-1, keepdims=True) + RMS_EPS)
    return (y * w.astype(jnp.float32)).astype(x.dtype)


def split_points():
    return [int(v) for v in np.cumsum(np.array(IN_SIZES))[:-1]]


def gla_chunked(q, k, v, gk):
    B, T, H, dk = q.shape
    dv = v.shape[-1]
    C = GLA_CHUNK
    N = T // C
    out_dtype = v.dtype

    def to_chunks(a):
        d = a.shape[-1]
        return a.astype(jnp.float32).reshape(B, N, C, H, d).transpose(1, 0, 3, 2, 4)

    qc, kc, vc, gc = to_chunks(q), to_chunks(k), to_chunks(v), to_chunks(gk)
    causal = jnp.tril(jnp.ones((C, C), dtype=bool))[:, :, None]

    def step(S, inp):
        qi, ki, vi, gi = inp
        b = jnp.cumsum(gi, axis=2)
        o_inter = jnp.einsum('bhcd,bhde->bhce', qi * jnp.exp(b), S)
        diff = b[:, :, :, None, :] - b[:, :, None, :, :]
        decay = jnp.where(causal, jnp.exp(jnp.where(causal, diff, 0.0)), 0.0)
        A = jnp.einsum('bhid,bhjd,bhijd->bhij', qi, ki, decay)
        o = o_inter + jnp.einsum('bhij,bhje->bhie', A, vi)
        b_last = b[:, :, -1]
        k_dec = ki * jnp.exp(b_last[:, :, None, :] - b)
        S = jnp.exp(b_last)[..., None] * S + jnp.einsum('bhcd,bhce->bhde', k_dec, vi)
        return S, o

    S0 = jnp.zeros((B, H, dk, dv), jnp.float32)
    _, o = lax.scan(step, S0, (qc, kc, vc, gc))
    return o.transpose(1, 0, 3, 2, 4).reshape(B, T, H, dv).astype(out_dtype)


def stick_breaking_attention(q, k, v):
    B, H, T, d = q.shape
    scale = 1.0 / math.sqrt(d)
    outs = []
    for i in range(T // SB_BLOCK):
        end = (i + 1) * SB_BLOCK
        q_blk = q[:, :, i * SB_BLOCK:end]
        k_blk = k[:, :, :end]
        v_blk = v[:, :, :end]
        z = jnp.einsum('bhqd,bhkd->bhqk', q_blk, k_blk).astype(jnp.float32) * scale
        t_idx = i * SB_BLOCK + jnp.arange(SB_BLOCK)[:, None]
        s_idx = jnp.arange(end)[None, :]
        strict = s_idx < t_idx
        log_beta = jax.nn.log_sigmoid(z)
        log_1m = jnp.where(strict, jax.nn.log_sigmoid(-z), 0.0)
        rev = lax.cumsum(log_1m, axis=3, reverse=True)
        log_A = log_beta + rev - log_1m
        A = jnp.where(strict, jnp.exp(log_A), 0.0)
        outs.append(jnp.einsum('bhqk,bhkd->bhqd', A, v_blk.astype(jnp.float32)).astype(v.dtype))
    return jnp.concatenate(outs, axis=2)


def parallel_mixer(h, w_in, w_gk_up, b_gk, gla_norm_w, sb_norm_w, w_out):
    B, T, _ = h.shape
    proj = h @ w_in
    q_g, k_g, v_g, g_g, gk_lr, q_s, k_s, v_s = jnp.split(proj, split_points(), axis=-1)
    q_g = q_g.reshape(B, T, GLA_HEADS, GLA_DK) * (GLA_DK ** -0.5)
    k_g = k_g.reshape(B, T, GLA_HEADS, GLA_DK)
    v_g = v_g.reshape(B, T, GLA_HEADS, GLA_DV)
    gk = (jax.nn.log_sigmoid((gk_lr @ w_gk_up + b_gk).astype(jnp.float32)) / GLA_GATE_NORMALIZER)
    gk = gk.reshape(B, T, GLA_HEADS, GLA_DK)
    o_g = gla_chunked(q_g, k_g, v_g, gk)
    o_g = rms_norm(o_g, gla_norm_w) * jax.nn.silu(g_g.reshape(B, T, GLA_HEADS, GLA_DV))
    o_g = o_g.reshape(B, T, GLA_V_W)
    def heads(a):
        return a.reshape(B, T, SB_HEADS, SB_HEAD_DIM).transpose(0, 2, 1, 3)
    o_s = stick_breaking_attention(heads(q_s), heads(k_s), heads(v_s)).transpose(0, 2, 1, 3)
    o_s = rms_norm(o_s, sb_norm_w).reshape(B, T, SB_WIDTH)
    return jnp.concatenate([o_g, o_s], axis=-1) @ w_out


def memory_cross_attention(h, mem_n, w_mq, w_mkv, mq_norm_w, mk_norm_w, w_mo):
    B, T, _ = h.shape
    M = mem_n.shape[1]
    q = rms_norm((h @ w_mq).reshape(B, T, MEM_HEADS, MEM_HEAD_DIM), mq_norm_w)
    kv = mem_n @ w_mkv
    k, v = jnp.split(kv, 2, axis=-1)
    k = rms_norm(k.reshape(B, M, MEM_HEADS, MEM_HEAD_DIM), mk_norm_w)
    v = v.reshape(B, M, MEM_HEADS, MEM_HEAD_DIM)
    s = jnp.einsum('bthd,bmhd->bhtm', q, k).astype(jnp.float32) / math.sqrt(MEM_HEAD_DIM)
    p = jax.nn.softmax(s, axis=-1).astype(v.dtype)
    o = jnp.einsum('bhtm,bmhd->bthd', p, v).reshape(B, T, D_MODEL)
    return o @ w_mo


def swiglu(h, w_gate_up, w_down):
    gate, up = jnp.split(h @ w_gate_up, 2, axis=-1)
    return (jax.nn.silu(gate) * up) @ w_down


def setup_inputs(seed: int = 0) -> dict:
    key = jax.random.key(seed)
    ks = jax.random.split(key, 24)
    f32 = jnp.float32

    def w(k, shape, fan_in):
        return jax.random.normal(k, (DEPTH,) + shape, f32) * (fan_in ** -0.5)

    def gain(k, n):
        return 1.0 + 0.01 * jax.random.normal(k, (DEPTH, n), f32)

    return {
        "x": jax.random.normal(ks[0], (BATCH, SEQ, D_MODEL), f32),
        "mem": jax.random.normal(ks[1], (BATCH, MEM_LEN, D_MODEL), f32),
        "mix_norm_w": gain(ks[2], D_MODEL),
        "w_in": w(ks[3], (D_MODEL, D_IN), D_MODEL),
        "w_gk_up": w(ks[4], (GLA_GATE_RANK, GLA_QK_W), GLA_GATE_RANK),
        "b_gk": 0.1 * jax.random.normal(ks[5], (DEPTH, GLA_QK_W), f32),
        "gla_norm_w": gain(ks[6], GLA_DV),
        "sb_norm_w": gain(ks[7], SB_HEAD_DIM),
        "w_out": w(ks[8], (MIX_WIDTH, D_MODEL), MIX_WIDTH),
        "xattn_norm_w": gain(ks[9], D_MODEL),
        "mem_norm_w": gain(ks[10], D_MODEL),
        "w_mq": w(ks[11], (D_MODEL, D_MODEL), D_MODEL),
        "w_mkv": w(ks[12], (D_MODEL, 2 * D_MODEL), D_MODEL),
        "mq_norm_w": gain(ks[13], MEM_HEAD_DIM),
        "mk_norm_w": gain(ks[14], MEM_HEAD_DIM),
        "w_mo": w(ks[15], (D_MODEL, D_MODEL), D_MODEL),
        "ffn_norm_w": gain(ks[16], D_MODEL),
        "w_gate_up": w(ks[17], (D_MODEL, 2 * D_FF), D_MODEL),
        "w_down": w(ks[18], (D_FF, D_MODEL), D_FF),
    }


def reference(x, mem, mix_norm_w, w_in, w_gk_up, b_gk, gla_norm_w, sb_norm_w, w_out,
              xattn_norm_w, mem_norm_w, w_mq, w_mkv, mq_norm_w, mk_norm_w, w_mo,
              ffn_norm_w, w_gate_up, w_down):
    for l in range(DEPTH):
        h = rms_norm(x, mix_norm_w[l])
        x = x + parallel_mixer(h, w_in[l], w_gk_up[l], b_gk[l], gla_norm_w[l], sb_norm_w[l], w_out[l])
        h = rms_norm(x, xattn_norm_w[l])
        mem_n = rms_norm(mem, mem_norm_w[l])
        x = x + memory_cross_attention(h, mem_n, w_mq[l], w_mkv[l], mq_norm_w[l], mk_norm_w[l], w_mo[l])
        h = rms_norm(x, ffn_norm_w[l])
        x = x + swiglu(h, w_gate_up[l], w_down[l])
    return x
```

```cpp
#include <hip/hip_runtime.h>
#include <hip/hip_cooperative_groups.h>
#include <cstdio>
#include <cstdint>
namespace cg = cooperative_groups;
namespace pg8 {
#define PG8_LAS __attribute__((address_space(3)))
typedef unsigned short bf16_t;
typedef short bf16x8 __attribute__((ext_vector_type(8)));
typedef float f32x4 __attribute__((ext_vector_type(4)));
typedef unsigned u32x4 __attribute__((ext_vector_type(4)));
constexpr int BM = 256, BK = 64, HALF = 128, HTB = HALF * BK * 2  , STAGE_BYTES = 8 * HTB, NXCD = 8, WGM = 4;

__host__ __device__ __forceinline__ int lds_byte(int r, int c) { const int st = (r >> 4) * 2 + (c >> 5), rr = r & 15, cc = c & 31, ob = rr * 64 + cc * 2; return st * 1024 + (ob ^ (((ob >> 9) & 1) << 5)); }
__host__ __device__ __forceinline__ void stage_rc(int b, int& R, int& C) { const int st = b / 1024, sb = b % 1024, swz = sb ^ (((sb >> 9) & 1) << 5); R = (st >> 1) * 16 + swz / 64; C = (st & 1) * 32 + (swz % 64) / 2; }
__host__ __device__ __forceinline__ int perm32(int rho) { const int n = rho >> 4, i = rho & 15; return 8 * (i >> 2) + 4 * n + (i & 3); }

struct Unit { int pm, pn; };
struct Gemm { const bf16_t* A; const bf16_t* Bt; int M, N, K; };

struct StaticOrder {
    int nM, nN, nwg, G, c;
    __host__ __device__ void init(int M, int N, int G_, int c_) { nM = M / BM; nN = N / BM; nwg = nM * nN; G = G_; c = c_; }
    __host__ __device__ bool next(int i, Unit& u) const {
        const long L = (long)i * G + c; if (L >= nwg) return false;
        int wgid = (int)L; { const int q = nwg / NXCD, r = nwg % NXCD, xcd = wgid % NXCD, off = wgid / NXCD; wgid = (xcd < r ? xcd * (q + 1) : r * (q + 1) + (xcd - r) * q) + off; }
        const int nig = WGM * nN, gid = wgid / nig, fm = gid * WGM, gsz = (nM - fm) < WGM ? (nM - fm) : WGM;
        u.pm = fm + ((wgid % nig) % gsz); u.pn = (wgid % nig) / gsz; return true;
    }
    __device__ __forceinline__ void a_ready(const Unit&) const {}
    __device__ __forceinline__ void done(const Unit&) const {}
};

__device__ __forceinline__ unsigned cvt_pk_bf16(float lo, float hi) { unsigned r; asm volatile("v_cvt_pk_bf16_f32 %0, %1, %2" : "=v"(r) : "v"(lo), "v"(hi)); return r; }
typedef float f32x2 __attribute__((ext_vector_type(2)));
typedef unsigned u32x2 __attribute__((ext_vector_type(2)));
__device__ __forceinline__ float hsum4(const f32x4 v) { return (v[0] + v[1]) + (v[2] + v[3]); }
__device__ __forceinline__ float dot4(const f32x4 v) { return (v[0] * v[0] + v[1] * v[1]) + (v[2] * v[2] + v[3] * v[3]); }
__device__ __forceinline__ float row_rstd16(const float* ssq, int row, float inv_n, float eps) {
    const f32x4* p = (const f32x4*)(ssq + (size_t)row * 16);
    const f32x4 a = p[0], b = p[1], c = p[2], d = p[3];
    return rsqrtf(((hsum4(a) + hsum4(b)) + (hsum4(c) + hsum4(d))) * inv_n + eps);
}
__device__ __forceinline__ float logsig_f(float v) { return fminf(v, 0.f) - __logf(1.0f + __expf(-fabsf(v))); }
__device__ __forceinline__ float silu_f(float g) { return g * __builtin_amdgcn_rcpf(1.0f + __expf(-g)); }
__device__ __forceinline__ u32x4 pack8(const f32x4 v0, const f32x4 v1) { u32x4 w; w.x = cvt_pk_bf16(v0[0], v0[1]); w.y = cvt_pk_bf16(v0[2], v0[3]); w.z = cvt_pk_bf16(v1[0], v1[1]); w.w = cvt_pk_bf16(v1[2], v1[3]); return w; }
template <int MODE> struct EpiScale {
    static constexpr bool PERM = true, AFTER_DRAIN = false;
    bf16_t* O; int ldc; const float* rs; const float* bias; float* ssq_out; const float* bias2;
    __device__ __forceinline__ void operator()(const f32x4 (&acc)[2][2][4][2], const Unit& u, int wr, int wc, int fr, int fq) const {
        const int row0 = u.pm * BM + wr * 64 + fr, col0 = u.pn * BM + wc * 32 + 8 * fq;
        const bool gk = (MODE == 0) && (u.pn == 6);
        f32x4 bv[2][2];
#pragma unroll
        for (int bj = 0; bj < 2; ++bj)
#pragma unroll
            for (int n = 0; n < 2; ++n) { if (MODE == 2) { const int cd = wc * 32 + 8 * fq + bj * HALF + 4 * n; bv[bj][n] = *(const f32x4*)(bias + cd) * *(const f32x4*)(bias2 + cd); }
                else bv[bj][n] = gk ? *(const f32x4*)(bias + (col0 - 1536) + bj * HALF + 4 * n) : (f32x4){0.f, 0.f, 0.f, 0.f}; }
        float sc8[2][4];
        if (MODE != 2) {
#pragma unroll
            for (int ai = 0; ai < 2; ++ai)
#pragma unroll
                for (int m = 0; m < 4; ++m) sc8[ai][m] = rs[row0 + ai * HALF + m * 16];
            asm volatile("" ::: "memory");
        }
#pragma unroll
        for (int ai = 0; ai < 2; ++ai)
#pragma unroll
            for (int m = 0; m < 4; ++m) {
                const int row = row0 + ai * HALF + m * 16;
                const float s = (MODE == 2) ? row_rstd16(rs, row, 1.0f / 1024.0f, 1e-6f) : sc8[ai][m];
                float q = 0.f;
#pragma unroll
                for (int bj = 0; bj < 2; ++bj) {
                    f32x4 v0 = acc[ai][bj][m][0] * s, v1 = acc[ai][bj][m][1] * s;
                    if (MODE == 0) { if (gk) {
#pragma unroll
                        for (int e = 0; e < 4; ++e) { v0[e] = logsig_f(v0[e] + bv[bj][0][e]) * 0.0625f; v1[e] = logsig_f(v1[e] + bv[bj][1][e]) * 0.0625f; } } }
                    if (MODE != 0) q += dot4(v0) + dot4(v1);
                    if (MODE == 2) { v0 = v0 * bv[bj][0]; v1 = v1 * bv[bj][1]; }
                    *(u32x4*)(O + (size_t)row * ldc + col0 + bj * HALF) = pack8(v0, v1);
                }
                if (MODE != 0) { q += __shfl_xor(q, 16); q += __shfl_xor(q, 32); if (fq == 0 && (MODE == 2 || u.pn < 4)) ssq_out[(size_t)row * 16 + u.pn * 4 + wc] = q; }
            }
    }
};
#ifndef RES_ROWS_BF16
#define RES_ROWS_BF16 4
#endif
template <int RES> struct EpiRes {
    static constexpr bool PERM = true, AFTER_DRAIN = false;
    static constexpr int RB = (RES == 0) ? 2 : RES_ROWS_BF16;
    const float* resid_f; const bf16_t* resid_b; float* out_f; bf16_t* out_b; float* ssq_out;
    __device__ __forceinline__ void operator()(const f32x4 (&acc)[2][2][4][2], const Unit& u, int wr, int wc, int fr, int fq) const {
        const int row0 = u.pm * BM + wr * 64 + fr, col0 = u.pn * BM + wc * 32 + 8 * fq;
#pragma unroll
        for (int g2 = 0; g2 < 8 / RB; ++g2) {
            f32x4 rf[RES == 0 ? RB : 1][2][2]; u32x4 rb[RES == 0 ? 1 : RB][2];
#pragma unroll
            for (int mm = 0; mm < RB; ++mm)
#pragma unroll
                for (int bj = 0; bj < 2; ++bj) { const int rr = g2 * RB + mm; const size_t off = (size_t)(row0 + (rr >> 2) * HALF + (rr & 3) * 16) * 1024 + col0 + bj * HALF;
                    if (RES == 0) { rf[mm][bj][0] = *(const f32x4*)(resid_f + off); rf[mm][bj][1] = *(const f32x4*)(resid_f + off + 4); } else rb[mm][bj] = *(const u32x4*)(resid_b + off); }
            asm volatile("" ::: "memory");
#pragma unroll
            for (int mm = 0; mm < RB; ++mm) {
                const int rr = g2 * RB + mm, ai = rr >> 2, m = rr & 3;
                const int row = row0 + ai * HALF + m * 16; float q = 0.f;
#pragma unroll
                for (int bj = 0; bj < 2; ++bj) {
                    const size_t off = (size_t)row * 1024 + col0 + bj * HALF;
                    f32x4 r0, r1;
                    if (RES == 0) { r0 = rf[mm][bj][0]; r1 = rf[mm][bj][1]; }
                    else { const u32x4 w = rb[mm][bj];
                        r0[0] = __builtin_bit_cast(float, w.x << 16); r0[1] = __builtin_bit_cast(float, w.x & 0xffff0000u); r0[2] = __builtin_bit_cast(float, w.y << 16); r0[3] = __builtin_bit_cast(float, w.y & 0xffff0000u);
                        r1[0] = __builtin_bit_cast(float, w.z << 16); r1[1] = __builtin_bit_cast(float, w.z & 0xffff0000u); r1[2] = __builtin_bit_cast(float, w.w << 16); r1[3] = __builtin_bit_cast(float, w.w & 0xffff0000u); }
                    const f32x4 v0 = acc[ai][bj][m][0] + r0, v1 = acc[ai][bj][m][1] + r1;
                    if (RES == 2) { *(f32x4*)(out_f + off) = v0; *(f32x4*)(out_f + off + 4) = v1; }
                    else { q += dot4(v0) + dot4(v1); *(u32x4*)(out_b + off) = pack8(v0, v1); }
                }
                if (RES != 2) { q += __shfl_xor(q, 16); q += __shfl_xor(q, 32); if (fq == 0) ssq_out[(size_t)row * 16 + u.pn * 4 + wc] = q; }
            }
        }
    }
};
struct RstdTab { const PG8_LAS float* tab; int p0, p1, p2, p3, p4, p5, p6, p7; };
template <class Sched> __device__ __forceinline__ RstdTab fill_rstd_table(const Sched& S, const float* ssq, PG8_LAS float* tab) {
    RstdTab T; T.tab = tab; T.p0 = T.p1 = T.p2 = T.p3 = T.p4 = T.p5 = T.p6 = T.p7 = -1;
    Unit u;
    for (int i = 0; S.next(i, u); ++i) { const int pm = u.pm; if (pm == T.p0 || pm == T.p1 || pm == T.p2 || pm == T.p3 || pm == T.p4 || pm == T.p5 || pm == T.p6 || pm == T.p7) continue;
        if (T.p0 < 0) T.p0 = pm; else if (T.p1 < 0) T.p1 = pm; else if (T.p2 < 0) T.p2 = pm; else if (T.p3 < 0) T.p3 = pm;
        else if (T.p4 < 0) T.p4 = pm; else if (T.p5 < 0) T.p5 = pm; else if (T.p6 < 0) T.p6 = pm; else if (T.p7 < 0) T.p7 = pm; }
    const int tid = threadIdx.x;
#pragma unroll
    for (int s2 = 0; s2 < 8; s2 += 2) { const int s = s2 + (tid >> 8);
        const int pm = (s == 0) ? T.p0 : (s == 1) ? T.p1 : (s == 2) ? T.p2 : (s == 3) ? T.p3 : (s == 4) ? T.p4 : (s == 5) ? T.p5 : (s == 6) ? T.p6 : T.p7;
        if (pm >= 0) tab[s * 256 + (tid & 255)] = row_rstd16(ssq, pm * BM + (tid & 255), 1.0f / 1024.0f, 1e-6f); }
    __syncthreads();
    return T;
}
__device__ __forceinline__ int rstd_slot(const RstdTab& T, int pm) { return (pm == T.p0) ? 0 : (pm == T.p1) ? 1 : (pm == T.p2) ? 2 : (pm == T.p3) ? 3 : (pm == T.p4) ? 4 : (pm == T.p5) ? 5 : (pm == T.p6) ? 6 : (pm == T.p7) ? 7 : -1; }
struct EpiGateUp {
    static constexpr bool PERM = true, AFTER_DRAIN = false;
    bf16_t* H; const float* ssq; RstdTab T;
    __device__ __forceinline__ void operator()(const f32x4 (&acc)[2][2][4][2], const Unit& u, int wr, int wc, int fr, int fq) const {
        const int row0 = u.pm * BM + wr * 64 + fr, col0 = u.pn * HALF + wc * 32 + 8 * fq;
        const int slot = rstd_slot(T, u.pm);
        float sc[2][4];
#pragma unroll
        for (int ai = 0; ai < 2; ++ai)
#pragma unroll
            for (int m = 0; m < 4; ++m) { const int rl = wr * 64 + fr + ai * HALF + m * 16;
                sc[ai][m] = (slot >= 0) ? T.tab[slot * 256 + rl] : row_rstd16(ssq, u.pm * BM + rl, 1.0f / 1024.0f, 1e-6f); }
#pragma unroll
        for (int ai = 0; ai < 2; ++ai)
#pragma unroll
            for (int m = 0; m < 4; ++m) {
                const int row = row0 + ai * HALF + m * 16;
                const float s = sc[ai][m];
                f32x4 h0, h1;
#pragma unroll
                for (int e = 0; e < 4; ++e) { h0[e] = silu_f(acc[ai][0][m][0][e] * s) * (acc[ai][1][m][0][e] * s); h1[e] = silu_f(acc[ai][0][m][1][e] * s) * (acc[ai][1][m][1][e] * s); }
                *(u32x4*)(H + (size_t)row * 2816 + col0) = pack8(h0, h1);
            }
    }
};
template <class Epi, class Sched, bool ALIGN_EPI = false, bool SP2 = false>
__device__ __forceinline__ void gemm_phase(PG8_LAS unsigned char* lds, const Gemm g, const Sched& S, const Epi& E) {
    const int tid = threadIdx.x, wid = __builtin_amdgcn_readfirstlane(tid >> 6), lane = tid & 63, wr = wid >> 2, wc = wid & 3, fr = lane & 15, fq = lane >> 4;
    const int K = g.K, nt = K / BK;
    unsigned voffA[2], voffB[2];
#pragma unroll
    for (int i = 0; i < 2; ++i) { int R, C; stage_rc(tid * 16 + i * 8192, R, C); const int Rb = Epi::PERM ? ((R & ~31) + perm32(R & 31)) : R;
        voffA[i] = (unsigned)(R * K + C) * 2u; voffB[i] = (unsigned)(Rb * K + C) * 2u; }
    const size_t kstep = (size_t)(BK * 2);
    const size_t hstep = (size_t)HALF * K * 2;
    const size_t tstep = 2 * hstep;
    const unsigned ldsw = (unsigned)wid * 1024u;
    const int aoff = lds_byte(wr * 64 + fr, fq * 8), boff = lds_byte(wc * 32 + fr, fq * 8);
#define PG8_SA(b, h) (((b) * 2 + (h)) * HTB)
#define PG8_SB(b, h) ((4 + (b) * 2 + (h)) * HTB)
#define PG8_STAGE(bufoff, gbase, voff) do { _Pragma("unroll") for (int _i = 0; _i < 2; ++_i) \
        __builtin_amdgcn_global_load_lds((const unsigned*)((const char*)(gbase) + (voff)[_i]), (PG8_LAS unsigned*)(lds + (bufoff) + ldsw + _i * 8192), 16, 0, 0); } while (0)
#define PG8_LDA(dst, b, h) do { _Pragma("unroll") for (int m = 0; m < 4; ++m) _Pragma("unroll") for (int k = 0; k < 2; ++k) dst[m][k] = *(const PG8_LAS bf16x8*)(lds + PG8_SA(b, h) + aoff + m * 2048 + k * 1024); } while (0)
#define PG8_LDB(dst, b, h) do { _Pragma("unroll") for (int n = 0; n < 2; ++n) _Pragma("unroll") for (int k = 0; k < 2; ++k) dst[n][k] = *(const PG8_LAS bf16x8*)(lds + PG8_SB(b, h) + boff + n * 2048 + k * 1024); } while (0)
#define PG8_MMA(ai, bj, At, Bt) do { __builtin_amdgcn_s_setprio(1); _Pragma("unroll") for (int m = 0; m < 4; ++m) _Pragma("unroll") for (int n = 0; n < 2; ++n) _Pragma("unroll") for (int k = 0; k < 2; ++k) \
        acc[ai][bj][m][n] = __builtin_amdgcn_mfma_f32_16x16x32_bf16(Bt[n][k], At[m][k], acc[ai][bj][m][n], 0, 0, 0); __builtin_amdgcn_s_setprio(0); } while (0)
#define PG8_WAIT_V(n) asm volatile("s_waitcnt vmcnt(" #n ")" ::: "memory")
#define PG8_WAIT_L(n) asm volatile("s_waitcnt lgkmcnt(" #n ")" ::: "memory")
#define PG8_BAR __builtin_amdgcn_s_barrier()
#define PG8_SCHED __builtin_amdgcn_sched_barrier(0)
    Unit cur, nxt; int ui = 0;
    if (!S.next(0, cur)) return;
    f32x4 acc[2][2][4][2];
#pragma unroll
    for (int a = 0; a < 2; ++a)
#pragma unroll
        for (int b = 0; b < 2; ++b)
#pragma unroll
            for (int m = 0; m < 4; ++m)
#pragma unroll
                for (int n = 0; n < 2; ++n) acc[a][b][m][n] = (f32x4){0.f, 0.f, 0.f, 0.f};
    bf16x8 At[4][2], B0[2][2], B1[2][2];
    const char* cA = (const char*)g.A + (size_t)cur.pm * tstep; const char* cB = (const char*)g.Bt + (size_t)cur.pn * tstep;
    S.a_ready(cur);
    if constexpr (SP2) {
        PG8_STAGE(PG8_SB(0, 0), cB, voffB); PG8_STAGE(PG8_SB(0, 1), cB + hstep, voffB); PG8_STAGE(PG8_SA(0, 0), cA, voffA); PG8_STAGE(PG8_SA(0, 1), cA + hstep, voffA);
        if (wr == 1) PG8_BAR;
        PG8_WAIT_V(2); PG8_BAR;
        PG8_STAGE(PG8_SB(1, 0), cB + kstep, voffB); PG8_STAGE(PG8_SA(1, 0), cA + kstep, voffA); PG8_STAGE(PG8_SB(1, 1), cB + hstep + kstep, voffB);
        PG8_WAIT_V(6); PG8_BAR;
    } else {
        PG8_STAGE(PG8_SB(0, 0), cB, voffB); PG8_STAGE(PG8_SA(0, 0), cA, voffA); PG8_STAGE(PG8_SB(0, 1), cB + hstep, voffB); PG8_STAGE(PG8_SA(0, 1), cA + hstep, voffA);
        if (wr == 1) PG8_BAR;
        PG8_WAIT_V(4); PG8_BAR;
        PG8_STAGE(PG8_SB(1, 0), cB + kstep, voffB); PG8_STAGE(PG8_SA(1, 0), cA + kstep, voffA); PG8_STAGE(PG8_SB(1, 1), cB + hstep + kstep, voffB);
        PG8_WAIT_V(6); PG8_BAR;
    }
    for (;;) {
        const bool has_next = S.next(ui + 1, nxt);
        const char* nA = has_next ? (const char*)g.A + (size_t)nxt.pm * tstep : cA; const char* nB = has_next ? (const char*)g.Bt + (size_t)nxt.pn * tstep : cB;
        for (int t = 0; t < nt; t += 2) {
            const bool last = (t == nt - 2);
            const char* a1 = cA + (size_t)(t + 1) * kstep;
            const char* a2 = last ? nA : cA + (size_t)(t + 2) * kstep; const char* b2 = last ? nB : cB + (size_t)(t + 2) * kstep;
            const char* a3 = a2 + kstep; const char* b3 = b2 + kstep;
            if (last && has_next) S.a_ready(nxt);
            if constexpr (SP2) {
            PG8_LDB(B0, 0, 0); PG8_LDB(B1, 0, 1); PG8_SCHED; PG8_LDA(At, 0, 0); PG8_STAGE(PG8_SA(1, 1), a1 + hstep, voffA);
            PG8_WAIT_V(8); PG8_WAIT_L(0); PG8_BAR; PG8_MMA(0, 0, At, B0); PG8_MMA(0, 1, At, B1); PG8_BAR; PG8_SCHED;
            PG8_LDA(At, 0, 1); PG8_STAGE(PG8_SB(0, 0), b2, voffB); PG8_STAGE(PG8_SB(0, 1), b2 + hstep, voffB); PG8_STAGE(PG8_SA(0, 0), a2, voffA);
            PG8_WAIT_V(8); PG8_WAIT_L(0); PG8_BAR; PG8_MMA(1, 0, At, B0); PG8_MMA(1, 1, At, B1); PG8_BAR; PG8_SCHED;
            PG8_LDB(B0, 1, 0); PG8_LDB(B1, 1, 1); PG8_SCHED; PG8_LDA(At, 1, 0); PG8_STAGE(PG8_SA(0, 1), a2 + hstep, voffA);
            PG8_WAIT_V(8); PG8_WAIT_L(0); PG8_BAR; PG8_MMA(0, 0, At, B0); PG8_MMA(0, 1, At, B1); PG8_BAR; PG8_SCHED;
            PG8_LDA(At, 1, 1); PG8_STAGE(PG8_SB(1, 0), b3, voffB); PG8_STAGE(PG8_SB(1, 1), b3 + hstep, voffB); PG8_STAGE(PG8_SA(1, 0), a3, voffA);
            PG8_WAIT_V(8); PG8_WAIT_L(0); PG8_BAR; PG8_MMA(1, 0, At, B0); PG8_MMA(1, 1, At, B1); PG8_BAR; PG8_SCHED;
            } else {
            PG8_LDB(B0, 0, 0); PG8_SCHED; PG8_LDA(At, 0, 0); PG8_STAGE(PG8_SA(1, 1), a1 + hstep, voffA);
            PG8_WAIT_L(8); PG8_BAR; PG8_WAIT_L(0); PG8_MMA(0, 0, At, B0); PG8_BAR; PG8_SCHED;
            PG8_LDB(B1, 0, 1); PG8_STAGE(PG8_SB(0, 0), b2, voffB);
            PG8_BAR; PG8_WAIT_L(0); PG8_MMA(0, 1, At, B1); PG8_BAR;
            PG8_LDA(At, 0, 1); PG8_STAGE(PG8_SA(0, 0), a2, voffA);
            PG8_BAR; PG8_WAIT_L(0); PG8_MMA(1, 0, At, B0); PG8_BAR; PG8_SCHED;
            PG8_STAGE(PG8_SB(0, 1), b2 + hstep, voffB);
            PG8_WAIT_V(6); PG8_BAR; PG8_MMA(1, 1, At, B1); PG8_BAR;
            PG8_LDB(B0, 1, 0); PG8_SCHED; PG8_LDA(At, 1, 0); PG8_STAGE(PG8_SA(0, 1), a2 + hstep, voffA);
            PG8_WAIT_L(8); PG8_BAR; PG8_WAIT_L(0); PG8_MMA(0, 0, At, B0); PG8_BAR; PG8_SCHED;
            PG8_LDB(B1, 1, 1); PG8_STAGE(PG8_SB(1, 0), b3, voffB);
            PG8_BAR; PG8_WAIT_L(0); PG8_MMA(0, 1, At, B1); PG8_BAR;
            PG8_LDA(At, 1, 1); PG8_STAGE(PG8_SA(1, 0), a3, voffA);
            PG8_BAR; PG8_WAIT_L(0); PG8_MMA(1, 0, At, B0); PG8_BAR; PG8_SCHED;
            PG8_STAGE(PG8_SB(1, 1), b3 + hstep, voffB);
            PG8_WAIT_V(6); PG8_BAR; PG8_MMA(1, 1, At, B1); PG8_BAR;
            }
        }
        if constexpr (ALIGN_EPI) { if (wr == 0) PG8_BAR; }
        if constexpr (!Epi::AFTER_DRAIN) { E(acc, cur, wr, wc, fr, fq); S.done(cur); }
        if (!has_next) break;
#pragma unroll
        for (int a = 0; a < 2; ++a)
#pragma unroll
            for (int b = 0; b < 2; ++b)
#pragma unroll
                for (int m = 0; m < 4; ++m)
#pragma unroll
                    for (int n = 0; n < 2; ++n) acc[a][b][m][n] = (f32x4){0.f, 0.f, 0.f, 0.f};
        cur = nxt; cA = nA; cB = nB; ++ui;
        if constexpr (ALIGN_EPI) { if (wr == 1) PG8_BAR; }
    }
    PG8_WAIT_V(0);
    if constexpr (!ALIGN_EPI) { if (wr == 0) PG8_BAR; }
    PG8_BAR;
    if constexpr (Epi::AFTER_DRAIN) { E.fused(acc, cur, wr, wc, fr, fq, lds, wid, lane); S.done(cur); }
#undef PG8_SA
#undef PG8_SB
#undef PG8_STAGE
#undef PG8_LDA
#undef PG8_LDB
#undef PG8_MMA
#undef PG8_WAIT_V
#undef PG8_WAIT_L
#undef PG8_BAR
#undef PG8_SCHED
}
}
#define LAS __attribute__((address_space(3)))
typedef unsigned short bf16;
typedef unsigned u32x4 __attribute__((ext_vector_type(4)));
typedef unsigned u32x2 __attribute__((ext_vector_type(2)));
typedef float f32x4 __attribute__((ext_vector_type(4)));
typedef short bf16x8 __attribute__((ext_vector_type(8)));
typedef unsigned long long u64;

constexpr int NB = 4, T = 8192, D = 1024, M = NB * T, NPROJ = 3328, DFF = 2816, MEML = 256, MROWS = NB * MEML;
constexpr int C_QG = 0, C_KG = 256, C_VG = 512, C_GG = 1024, C_GK = 1536, C_QS = 1792, C_KS = 2304, C_VS = 2816;
constexpr float EPS = 1e-6f;
constexpr size_t MiB = 1u << 20;
constexpr size_t WS_WIN = 0, WS_WOUT = 7 * MiB, WS_WMQ = 9 * MiB, WS_WMKV = 11 * MiB, WS_WMO = 15 * MiB, WS_WGU = 17 * MiB, WS_WDN = 28 * MiB;
constexpr size_t WS_RS0 = 34 * MiB, WS_RSM = 34 * MiB + 128 * 1024, WS_SSQK = 34 * MiB + 256 * 1024, WS_SSQ1 = 35 * MiB, WS_SSQ2 = 37 * MiB, WS_SSQQ = 39 * MiB;
constexpr size_t WS_MEMB = 41 * MiB, WS_KV = 43 * MiB, WS_DEC = 47 * MiB, WS_CTL = 47 * MiB + 768 * 1024;
constexpr size_t WS_R0 = 48 * MiB, WS_R1 = 256 * MiB, WS_R2 = 320 * MiB, WS_R3 = 384 * MiB, WS_STB = 448 * MiB, WS_END = 480 * MiB;
static_assert(WS_R0 + (size_t)M * NPROJ * 2 <= WS_R1 && WS_WDN + (size_t)D * DFF * 2 <= WS_RS0, "ws map");
constexpr int LDS_BYTES = 147456;
constexpr int NTHR = 512;

__device__ __forceinline__ unsigned f2bf(float f) { unsigned u = __builtin_bit_cast(unsigned, f); return (u + 0x7fffu + ((u >> 16) & 1u)) >> 16; }
typedef float f32x2c __attribute__((ext_vector_type(2)));
typedef __bf16 bf16x2c __attribute__((ext_vector_type(2)));
__device__ __forceinline__ unsigned pk2(float lo, float hi) { const f32x2c v = {lo, hi}; const bf16x2c b = __builtin_convertvector(v, bf16x2c); return __builtin_bit_cast(unsigned, b); }
__device__ __forceinline__ float bf2f(unsigned short h) { return __builtin_bit_cast(float, (unsigned)h << 16); }
__device__ __forceinline__ float bflo(unsigned w) { return __builtin_bit_cast(float, w << 16); }
__device__ __forceinline__ float bfhi(unsigned w) { return __builtin_bit_cast(float, w & 0xffff0000u); }
__device__ __forceinline__ float wave_sum(float v) {
#pragma unroll
    for (int o = 1; o < 64; o <<= 1) v += __shfl_xor(v, o);
    return v;
}
__device__ __forceinline__ bf16x8 mk8(u32x4 w) { return __builtin_bit_cast(bf16x8, w); }
__device__ __forceinline__ bf16x8 mk8(u32x2 lo, u32x2 hi) { u32x4 w; w.x = lo.x; w.y = lo.y; w.z = hi.x; w.w = hi.y; return __builtin_bit_cast(bf16x8, w); }
__device__ __forceinline__ bf16x8 pk8(const f32x4 a, const f32x4 b) { u32x4 w; w.x = pk2(a[0], a[1]); w.y = pk2(a[2], a[3]); w.z = pk2(b[0], b[1]); w.w = pk2(b[2], b[3]); return __builtin_bit_cast(bf16x8, w); }
#define MFMA16(a, b, c) __builtin_amdgcn_mfma_f32_16x16x32_bf16((a), (b), (c), 0, 0, 0)
#define LDS_FENCE() asm volatile("s_waitcnt lgkmcnt(0)" ::: "memory")

#define XB_TMO      128
#define XB_XCNT(j)  (256  + 64 * (j))
#define XB_XSUB(j)  (1280 + 64 * (j))
#define XB_XGEN(j)  (2304 + 64 * (j))
#define XB_TOP      3328
#define XB_TOPGEN   3392
#define XCD_BAR_WORDS 3456
#define XB_SPIN_CAP (1u << 18)

__device__ __forceinline__ unsigned xb_ld(unsigned* p)              { return __hip_atomic_load(p, __ATOMIC_RELAXED, __HIP_MEMORY_SCOPE_AGENT); }
__device__ __forceinline__ unsigned xb_add(unsigned* p, unsigned v) { return __hip_atomic_fetch_add(p, v, __ATOMIC_RELAXED, __HIP_MEMORY_SCOPE_AGENT); }
__device__ __forceinline__ unsigned xb_xcc_id() { return (unsigned)__builtin_amdgcn_s_getreg((3 << 11) | 20) & 0xFu; }
#define XB_SPIN(cond, bar) do { unsigned _sp = 0; while (cond) { __builtin_amdgcn_s_sleep(1); \
    if ((++_sp & 255u) == 0u) { if (xb_ld(&(bar)[XB_TMO])) break; if (_sp > XB_SPIN_CAP) { atomicAdd(&(bar)[XB_TMO], 1u); break; } } } } while (0)

struct XcdBarrier {
    unsigned* bar; unsigned x;
    volatile LAS unsigned* st;
};

__device__ __forceinline__ XcdBarrier xcd_barrier_post(unsigned* bar, volatile LAS unsigned* st) {
    XcdBarrier b; b.bar = bar; b.x = xb_xcc_id(); b.st = st;
    if (threadIdx.x == 0) (void)xb_add(&bar[XB_XCNT(b.x)], 1u);
    return b;
}
__device__ __forceinline__ void xcd_barrier_complete(unsigned* bar, unsigned x, unsigned& nloc, unsigned& nx) {
    const unsigned G = gridDim.x * gridDim.y * gridDim.z;
    unsigned sum, cnt, mine, sp = 0u;
    for (;;) {
        sum = 0u; cnt = 0u; mine = 0u;
#pragma unroll
        for (unsigned j = 0; j < 16; ++j) { const unsigned c = xb_ld(&bar[XB_XCNT(j)]); sum += c; cnt += (c > 0u) ? 1u : 0u; mine = (j == x) ? c : mine; }
        if (sum == G) break;
        __builtin_amdgcn_s_sleep(1);
        if ((++sp & 255u) == 0u) { if (xb_ld(&bar[XB_TMO])) break; if (sp > XB_SPIN_CAP) { atomicAdd(&bar[XB_TMO], 1u); break; } }
    }
    nloc = mine > 0u ? mine : 1u; nx = cnt > 0u ? cnt : 1u;
}

__device__ __forceinline__ void xcd_barrier(const XcdBarrier& b) {
    asm volatile("s_waitcnt vmcnt(0)" ::: "memory");
    __syncthreads();
    if (threadIdx.x == 0) {
        unsigned* bar = b.bar;
        __builtin_amdgcn_s_waitcnt(0);
        unsigned nloc = b.st[0], nx = b.st[1];
        if (nloc == 0u) { xcd_barrier_complete(bar, b.x, nloc, nx); b.st[0] = nloc; b.st[1] = nx; }
        const unsigned old = xb_add(&bar[XB_XSUB(b.x)], 1u);
        const unsigned gen = old / nloc;
        if (old + 1u == (gen + 1u) * nloc) {
            __builtin_amdgcn_fence(__ATOMIC_RELEASE, "agent");
            asm volatile("s_waitcnt vmcnt(0)" ::: "memory");
            const unsigned og = xb_add(&bar[XB_TOP], 1u);
            const unsigned tg = og / nx;
            if (og + 1u == (tg + 1u) * nx) xb_add(&bar[XB_TOPGEN], 1u);
            else XB_SPIN(xb_ld(&bar[XB_TOPGEN]) == tg, bar);
            __builtin_amdgcn_fence(__ATOMIC_ACQUIRE, "agent");
            xb_add(&bar[XB_XGEN(b.x)], 1u);
            asm volatile("s_waitcnt vmcnt(0)" ::: "memory");
        } else {
            XB_SPIN(xb_ld(&bar[XB_XGEN(b.x)]) == gen, bar);
            __builtin_amdgcn_fence(__ATOMIC_ACQUIRE, "agent");
            asm volatile("s_waitcnt vmcnt(0)" ::: "memory");
        }
    }
    __syncthreads();
}

struct Args {
    const float *x, *mem, *mix_nw, *w_in, *w_gk_up, *b_gk, *gla_nw, *sb_nw, *w_out, *xat_nw, *mem_nw, *w_mq, *w_mkv, *mq_nw, *mk_nw, *w_mo, *ffn_nw, *w_gu, *w_dn;
    float* out; unsigned char* ws;
};

__device__ __forceinline__ void tr_item(const float* W, int ldw, int K, const float* kscale, float cscale, bf16* WT, int k0, int n0src, int drow0, LAS float* scr, int lane, const float* kscale2 = nullptr) {
#pragma unroll
    for (int i = 0; i < 32; ++i) { const int kk = 2 * i + (lane >> 5); const float ks = kscale2 ? ((k0 + kk) < 512 ? kscale[(k0 + kk) & 127] : kscale2[(k0 + kk) & 63]) : (kscale ? kscale[k0 + kk] : 1.0f);
        scr[kk * 33 + (lane & 31)] = W[(size_t)(k0 + kk) * ldw + n0src + (lane & 31)] * (ks * cscale); }
    LDS_FENCE();
    const int c = lane & 7;
#pragma unroll
    for (int j = 0; j < 4; ++j) { const int n = (lane >> 3) + 8 * j; const LAS float* s = scr + (8 * c) * 33 + n;
        u32x4 o; o.x = pk2(s[0 * 33], s[1 * 33]); o.y = pk2(s[2 * 33], s[3 * 33]); o.z = pk2(s[4 * 33], s[5 * 33]); o.w = pk2(s[6 * 33], s[7 * 33]);
        *(u32x4*)(WT + (size_t)(drow0 + n) * K + k0 + 8 * c) = o; }
    LDS_FENCE();
}
__device__ __forceinline__ void row_to_bf16_rs(const float* xrow, bf16* orow, float* rs_out, int lane) {
    const f32x4* xr = (const f32x4*)xrow + lane;
    f32x4 v[4]; float s = 0.f;
#pragma unroll
    for (int j = 0; j < 4; ++j) { v[j] = xr[64 * j]; s += pg8::dot4(v[j]); }
    s = wave_sum(s);
    if (lane == 0) *rs_out = rsqrtf(s * (1.0f / 1024.0f) + EPS);
    u64* o8 = (u64*)orow + lane;
#pragma unroll
    for (int j = 0; j < 4; ++j) o8[64 * j] = (u64)pk2(v[j][0], v[j][1]) | ((u64)pk2(v[j][2], v[j][3]) << 32);
}

__device__ __forceinline__ void p0_do_item(const Args& a, int it, LAS float* scr, int lane) {
    unsigned char* ws = a.ws;
    constexpr int I_INA = 16 * 48, I_INB = 16 * 48, I_SQ = 16 * 32, I_MKV = 16 * 64, I_GU = 16 * 176, I_DN = 44 * 32;
        int r = it;
        if (r < I_INA) { const int kb = r / 48, nb = r % 48, n0 = 32 * nb; tr_item(a.w_in, 3088, 1024, a.mix_nw, n0 < 256 ? 0.125f : 1.0f, (bf16*)(ws + WS_WIN), 64 * kb, n0, n0, scr, lane); return; } r -= I_INA;
        if (r < I_INB) { const int kb = r / 48, nb = r % 48, n0 = 32 * nb; tr_item(a.w_in, 3088, 1024, a.mix_nw, n0 < 512 ? 0.125f * 1.44269504f : 1.0f, (bf16*)(ws + WS_WIN), 64 * kb, 1552 + n0, 1792 + n0, scr, lane); return; } r -= I_INB;
        if (r < I_SQ) { const int kb = r / 32, nb = r % 32; tr_item(a.w_out, 1024, 1024, a.gla_nw, 1.0f, (bf16*)(ws + WS_WOUT), 64 * kb, 32 * nb, 32 * nb, scr, lane, a.sb_nw); return; } r -= I_SQ;
        if (r < I_SQ) { const int kb = r / 32, nb = r % 32; tr_item(a.w_mq, 1024, 1024, a.xat_nw, 1.0f, (bf16*)(ws + WS_WMQ), 64 * kb, 32 * nb, 32 * nb, scr, lane); return; } r -= I_SQ;
        if (r < I_SQ) { const int kb = r / 32, nb = r % 32; tr_item(a.w_mo, 1024, 1024, nullptr, 1.0f, (bf16*)(ws + WS_WMO), 64 * kb, 32 * nb, 32 * nb, scr, lane); return; } r -= I_SQ;
        if (r < I_MKV) { const int kb = r / 64, nb = r % 64; tr_item(a.w_mkv, 2048, 1024, a.mem_nw, 1.0f, (bf16*)(ws + WS_WMKV), 64 * kb, 32 * nb, 32 * nb, scr, lane); return; } r -= I_MKV;
        if (r < I_GU) { const int kb = r / 176, nb = r % 176, n0 = 32 * nb; const int j0 = n0 < DFF ? n0 : n0 - DFF; const int dr = 256 * (j0 / 128) + (j0 % 128) + (n0 < DFF ? 0 : 128);
            tr_item(a.w_gu, 2 * DFF, 1024, a.ffn_nw, 1.0f, (bf16*)(ws + WS_WGU), 64 * kb, n0, dr, scr, lane); return; } r -= I_GU;
        { const int kb = r / 32, nb = r % 32; tr_item(a.w_dn, 1024, DFF, nullptr, 1.0f, (bf16*)(ws + WS_WDN), 64 * kb, 32 * nb, 32 * nb, scr, lane); }
}
__device__ __forceinline__ void p0_prologue(const Args& a, LAS unsigned char* lds, int wid, int lane, int G) {
    unsigned char* ws = a.ws;
    LAS float* scr = (LAS float*)(lds + wid * 16384);
    const int gw = blockIdx.x * 8 + wid, NGW = G * 8;
    constexpr int NITEMS = 16 * 48 * 2 + 3 * 16 * 32 + 16 * 64 + 16 * 176 + 44 * 32;
    {
        int it = gw, m4 = gw * 4;
        while (it < NITEMS || m4 < M) {
            const bool hx = m4 < M;
            f32x4 v[4][4];
            if (hx) {
#pragma unroll
                for (int r = 0; r < 4; ++r) { const f32x4* xr = (const f32x4*)(a.x + (size_t)(m4 + r) * D) + lane;
#pragma unroll
                    for (int jj = 0; jj < 4; ++jj) v[r][jj] = xr[64 * jj]; }
            }
            if (it < NITEMS) { p0_do_item(a, it, scr, lane); it += NGW; }
            if (hx) {
                float s[4];
#pragma unroll
                for (int r = 0; r < 4; ++r) { float t = 0.f;
#pragma unroll
                    for (int jj = 0; jj < 4; ++jj) t += pg8::dot4(v[r][jj]);
                    s[r] = wave_sum(t); }
#pragma unroll
                for (int r = 0; r < 4; ++r) { if (lane == 0) ((float*)(ws + WS_RS0))[m4 + r] = rsqrtf(s[r] * (1.0f / 1024.0f) + EPS);
                    u64* o8 = (u64*)((bf16*)(ws + WS_R2) + (size_t)(m4 + r) * D) + lane;
#pragma unroll
                    for (int jj = 0; jj < 4; ++jj) o8[64 * jj] = (u64)pk2(v[r][jj][0], v[r][jj][1]) | ((u64)pk2(v[r][jj][2], v[r][jj][3]) << 32); }
                m4 += NGW * 4;
            }
        }
    }
    {
        bf16* WT = (bf16*)(ws + WS_WIN);
        for (int it = blockIdx.x * NTHR + threadIdx.x; it < 256 * 512; it += G * NTHR) {
            const int j = it & 255, k0 = (it >> 8) * 2;
            float up[16];
#pragma unroll
            for (int r = 0; r < 16; ++r) up[r] = a.w_gk_up[r * 256 + j];
            float o[2];
#pragma unroll
            for (int e = 0; e < 2; ++e) { const f32x4* wr_ = (const f32x4*)(a.w_in + (size_t)(k0 + e) * 3088 + 1536); float s = 0.f;
#pragma unroll
                for (int r4 = 0; r4 < 4; ++r4) { const f32x4 wv = wr_[r4]; s += wv[0] * up[4 * r4] + wv[1] * up[4 * r4 + 1] + wv[2] * up[4 * r4 + 2] + wv[3] * up[4 * r4 + 3]; }
                o[e] = s * a.mix_nw[k0 + e]; }
            *(unsigned*)(WT + (size_t)(1536 + j) * 1024 + k0) = pk2(o[0], o[1]);
        }
    }
    for (int m = gw; m < MROWS; m += NGW) row_to_bf16_rs(a.mem + (size_t)m * D, (bf16*)(ws + WS_MEMB) + (size_t)m * D, (float*)(ws + WS_RSM) + m, lane);
}

constexpr int GL_HALF = 73728, GL_BF = 0, GL_KDT = 16640, GL_VT = 25856, GL_QE = 44288, GL_KE = 53504, GL_QB = 62720, GL_TOT = 71936;
struct GlaRaw { float gk[16]; u32x4 q[2]; u32x4 k[2]; u32x4 v[4]; };
template <bool WITHQ, int PART> __device__ __forceinline__ void gla_load_raw(GlaRaw& r, const bf16* PROJ, int unit, int hw, int th) {
    const int c = 2 * unit + hw, bh = c >> 7, n = c & 127, b = bh >> 2, h = bh & 3;
    const size_t row0 = (size_t)b * T + (size_t)n * 64;
    const int d = th & 63, seg = th >> 6, t = th >> 2, dseg = (th & 3) * 16;
    const bf16* gkp = PROJ + row0 * NPROJ + C_GK + h * 64;
    if (PART == 0) {
#pragma unroll
        for (int i = 0; i < 16; ++i) r.gk[i] = bf2f(gkp[(size_t)(16 * seg + i) * NPROJ + d]);
        return;
    }
    const bf16* kp = PROJ + (row0 + t) * NPROJ + C_KG + h * 64 + dseg; r.k[0] = *(const u32x4*)kp; r.k[1] = *(const u32x4*)(kp + 8);
    if (WITHQ) { const bf16* qp = PROJ + (row0 + t) * NPROJ + C_QG + h * 64 + dseg; r.q[0] = *(const u32x4*)qp; r.q[1] = *(const u32x4*)(qp + 8); }
    const bf16* vp = PROJ + (row0 + t) * NPROJ + C_VG + h * 128 + (th & 3) * 32;
#pragma unroll
    for (int i = 0; i < 4; ++i) r.v[i] = *(const u32x4*)(vp + 8 * i);
}
__device__ __forceinline__ void gla_cumsum_r(LAS float* Bf, LAS float* Tot, const GlaRaw& r, int th) {
    const int d = th & 63, seg = th >> 6;
    float acc[16]; float run = 0.f;
#pragma unroll
    for (int i = 0; i < 16; ++i) { run += r.gk[i]; acc[i] = run; }
    Tot[seg * 64 + d] = run;
    __syncthreads();
    float off = 0.f;
#pragma unroll
    for (int s = 0; s < 3; ++s) if (s < seg) off += Tot[s * 64 + d];
#pragma unroll
    for (int i = 0; i < 16; ++i) Bf[(16 * seg + i) * 65 + d] = acc[i] + off;
    __syncthreads();
}
__device__ __forceinline__ void gla_store_vt(LAS bf16* VT, const GlaRaw& r, int t, int dvseg) {
#pragma unroll
    for (int i = 0; i < 4; ++i)
#pragma unroll
        for (int e = 0; e < 4; ++e) { VT[(dvseg + 8 * i + 2 * e) * 72 + t] = (bf16)(r.v[i][e] & 0xffffu); VT[(dvseg + 8 * i + 2 * e + 1) * 72 + t] = (bf16)(r.v[i][e] >> 16); }
}
__device__ __forceinline__ void gla_pass_a_all(const Args& a, LAS unsigned char* lds, int G) {
    const int tid = threadIdx.x, wid = tid >> 6, lane = tid & 63, hw = wid >> 2, wq = wid & 3, th = tid & 255, fr = lane & 15, fq = lane >> 4;
    const bf16* PROJ = (const bf16*)(a.ws + WS_R0); bf16* ST = (bf16*)(a.ws + WS_R3); float* DEC = (float*)(a.ws + WS_DEC);
    LAS unsigned char* L = lds + hw * GL_HALF;
    LAS float* Bf = (LAS float*)(L + GL_BF); LAS float* Tot = (LAS float*)(L + GL_TOT); LAS bf16* KdT = (LAS bf16*)(L + GL_KDT); LAS bf16* VT = (LAS bf16*)(L + GL_VT);
    int unit = blockIdx.x; if (unit >= 1024) return;
    GlaRaw r; gla_load_raw<false, 0>(r, PROJ, unit, hw, th);
    for (; unit < 1024; unit += G) {
        const int c = 2 * unit + hw;
        gla_load_raw<false, 1>(r, PROJ, unit, hw, th);
        gla_cumsum_r(Bf, Tot, r, th);
        {
            const int t = th >> 2, dseg = (th & 3) * 16;
#pragma unroll
            for (int i = 0; i < 16; ++i) { const int d = dseg + i; const unsigned w = (i < 8) ? r.k[0][(i & 7) >> 1] : r.k[1][(i & 7) >> 1]; const float kv = (i & 1) ? bfhi(w) : bflo(w);
                KdT[d * 72 + t] = (bf16)f2bf(kv * __expf(Bf[63 * 65 + d] - Bf[t * 65 + d])); }
            gla_store_vt(VT, r, t, (th & 3) * 32);
            if (th < 64) DEC[(size_t)c * 64 + th] = __expf(Bf[63 * 65 + th]);
        }
        __syncthreads();
        if (unit + G < 1024) gla_load_raw<false, 0>(r, PROJ, unit + G, hw, th);
#pragma unroll
        for (int dvi = 0; dvi < 2; ++dvi) {
            const int dvb = 2 * wq + dvi;
            const bf16x8 a0 = *(const LAS bf16x8*)(VT + (16 * dvb + fr) * 72 + 8 * fq), a1 = *(const LAS bf16x8*)(VT + (16 * dvb + fr) * 72 + 32 + 8 * fq);
#pragma unroll
            for (int dkb = 0; dkb < 4; ++dkb) {
                const bf16x8 b0 = *(const LAS bf16x8*)(KdT + (16 * dkb + fr) * 72 + 8 * fq), b1 = *(const LAS bf16x8*)(KdT + (16 * dkb + fr) * 72 + 32 + 8 * fq);
                f32x4 acc = {0.f, 0.f, 0.f, 0.f};
                acc = MFMA16(a0, b0, acc); acc = MFMA16(a1, b1, acc);
#pragma unroll
                for (int rr = 0; rr < 4; ++rr) ST[(size_t)c * 8192 + (16 * dvb + 4 * fq + rr) * 64 + 16 * dkb + fr] = (bf16)f2bf(acc[rr]);
            }
        }
        __syncthreads();
    }
}
typedef float f32x2s __attribute__((ext_vector_type(2)));
__device__ __forceinline__ void gla_scan_w(const Args& a, int G, int t256) {
    const unsigned* UT = (const unsigned*)(a.ws + WS_R3); const float* DEC = (const float*)(a.ws + WS_DEC); unsigned* STB = (unsigned*)(a.ws + WS_STB);
    for (int base = blockIdx.x * 512; base < 16 * 8192; base += G * 512) {
        const int bh = base >> 13, e0 = (base & 8191) + 2 * t256, dk = e0 & 63;
        float S0 = 0.f, S1 = 0.f;
        for (int n0 = 0; n0 < 128; n0 += 32) {
            unsigned u[32]; f32x2s dc[32];
#pragma unroll
            for (int i = 0; i < 32; ++i) { const size_t c = (size_t)bh * 128 + n0 + i; dc[i] = *(const f32x2s*)(DEC + c * 64 + dk); u[i] = UT[(c * 8192 + e0) >> 1]; }
#pragma unroll
            for (int i = 0; i < 32; ++i) { const size_t c = (size_t)bh * 128 + n0 + i;
                STB[(c * 8192 + e0) >> 1] = pk2(S0, S1); S0 = dc[i][0] * S0 + bflo(u[i]); S1 = dc[i][1] * S1 + bfhi(u[i]); }
        }
    }
}
__device__ __forceinline__ void gla_pass_c_all(const Args& a, LAS unsigned char* lds, int G) {
    const int tid = threadIdx.x, wid = tid >> 6, lane = tid & 63, hw = wid >> 2, ib = wid & 3, th = tid & 255, fr = lane & 15, fq = lane >> 4;
    const bf16* PROJ = (const bf16*)(a.ws + WS_R0); const bf16* STB = (const bf16*)(a.ws + WS_STB); bf16* MIX = (bf16*)(a.ws + WS_R1);
    LAS unsigned char* L = lds + hw * GL_HALF;
    LAS float* Bf = (LAS float*)(L + GL_BF); LAS float* Tot = (LAS float*)(L + GL_TOT); LAS bf16* VT = (LAS bf16*)(L + GL_VT);
    LAS bf16* QE = (LAS bf16*)(L + GL_QE); LAS bf16* KE = (LAS bf16*)(L + GL_KE); LAS bf16* QB = (LAS bf16*)(L + GL_QB);
    int unit = blockIdx.x; if (unit >= 1024) return;
    GlaRaw r; gla_load_raw<true, 0>(r, PROJ, unit, hw, th);
    for (; unit < 1024; unit += G) {
        const int c = 2 * unit + hw, bh = c >> 7, n = c & 127, b = bh >> 2, h = bh & 3;
        const size_t row0 = (size_t)b * T + (size_t)n * 64;
        const size_t tok = row0 + 16 * ib + fr;
        gla_load_raw<true, 1>(r, PROJ, unit, hw, th);
        u32x2 gw[8];
#pragma unroll
        for (int dvb = 0; dvb < 8; ++dvb) gw[dvb] = *(const u32x2*)(PROJ + tok * NPROJ + C_GG + h * 128 + 16 * dvb + 4 * fq);
        gla_cumsum_r(Bf, Tot, r, th);
        {
            const int t = th >> 2, dseg = (th & 3) * 16;
            float qe[16], ke[16], qb[16];
#pragma unroll
            for (int i = 0; i < 16; ++i) { const int d = dseg + i; const unsigned wq_ = (i < 8) ? r.q[0][(i & 7) >> 1] : r.q[1][(i & 7) >> 1], wk_ = (i < 8) ? r.k[0][(i & 7) >> 1] : r.k[1][(i & 7) >> 1];
                const float qv = (i & 1) ? bfhi(wq_) : bflo(wq_), kv = (i & 1) ? bfhi(wk_) : bflo(wk_);
                const float bt = Bf[t * 65 + d], br = Bf[31 * 65 + d]; const float dl = fminf(fmaxf(bt - br, -80.f), 80.f);
                qe[i] = qv * __expf(dl); ke[i] = kv * __expf(-dl); qb[i] = qv * __expf(bt); }
#pragma unroll
            for (int v = 0; v < 2; ++v) {
                u32x4 w;
                w.x = pk2(qe[8 * v + 0], qe[8 * v + 1]); w.y = pk2(qe[8 * v + 2], qe[8 * v + 3]); w.z = pk2(qe[8 * v + 4], qe[8 * v + 5]); w.w = pk2(qe[8 * v + 6], qe[8 * v + 7]); *(LAS u32x4*)(QE + t * 72 + dseg + 8 * v) = w;
                w.x = pk2(ke[8 * v + 0], ke[8 * v + 1]); w.y = pk2(ke[8 * v + 2], ke[8 * v + 3]); w.z = pk2(ke[8 * v + 4], ke[8 * v + 5]); w.w = pk2(ke[8 * v + 6], ke[8 * v + 7]); *(LAS u32x4*)(KE + t * 72 + dseg + 8 * v) = w;
                w.x = pk2(qb[8 * v + 0], qb[8 * v + 1]); w.y = pk2(qb[8 * v + 2], qb[8 * v + 3]); w.z = pk2(qb[8 * v + 4], qb[8 * v + 5]); w.w = pk2(qb[8 * v + 6], qb[8 * v + 7]); *(LAS u32x4*)(QB + t * 72 + dseg + 8 * v) = w;
            }
            gla_store_vt(VT, r, t, (th & 3) * 32);
        }
        bf16x8 sfr[8][2];
#pragma unroll
        for (int dvb = 0; dvb < 8; ++dvb) { const bf16* sp = STB + (size_t)c * 8192 + (16 * dvb + fr) * 64 + 8 * fq; sfr[dvb][0] = *(const bf16x8*)sp; sfr[dvb][1] = *(const bf16x8*)(sp + 32); }
        __syncthreads();
        if (unit + G < 1024) gla_load_raw<true, 0>(r, PROJ, unit + G, hw, th);
        {
            f32x4 accA[4];
            const bf16x8 qe0 = *(const LAS bf16x8*)(QE + (16 * ib + fr) * 72 + 8 * fq), qe1 = *(const LAS bf16x8*)(QE + (16 * ib + fr) * 72 + 32 + 8 * fq);
#pragma unroll
            for (int jb = 0; jb < 4; ++jb) {
                accA[jb] = (f32x4){0.f, 0.f, 0.f, 0.f};
                if (jb <= ib) {
                    const bf16x8 ke0 = *(const LAS bf16x8*)(KE + (16 * jb + fr) * 72 + 8 * fq), ke1 = *(const LAS bf16x8*)(KE + (16 * jb + fr) * 72 + 32 + 8 * fq);
                    accA[jb] = MFMA16(ke0, qe0, accA[jb]); accA[jb] = MFMA16(ke1, qe1, accA[jb]);
                    if (jb == ib) {
#pragma unroll
                        for (int rr = 0; rr < 4; ++rr) if (4 * fq + rr > fr) accA[jb][rr] = 0.f;
                    }
                }
            }
            const bf16x8 P0 = pk8(accA[0], accA[1]), P1 = pk8(accA[2], accA[3]);
            const bf16x8 qb0 = *(const LAS bf16x8*)(QB + (16 * ib + fr) * 72 + 8 * fq), qb1 = *(const LAS bf16x8*)(QB + (16 * ib + fr) * 72 + 32 + 8 * fq);
            f32x4 o[8]; float ssq = 0.f;
#pragma unroll
            for (int dvb = 0; dvb < 8; ++dvb) {
                f32x4 acc = {0.f, 0.f, 0.f, 0.f};
                const LAS bf16* vrow = VT + (16 * dvb + fr) * 72 + 4 * fq;
                { const bf16x8 av = mk8(*(const LAS u32x2*)(vrow), *(const LAS u32x2*)(vrow + 16)); acc = MFMA16(av, P0, acc); }
                if (ib >= 2) { const bf16x8 av = mk8(*(const LAS u32x2*)(vrow + 32), *(const LAS u32x2*)(vrow + 48)); acc = MFMA16(av, P1, acc); }
                acc = MFMA16(sfr[dvb][0], qb0, acc);
                acc = MFMA16(sfr[dvb][1], qb1, acc);
                o[dvb] = acc; ssq += pg8::dot4(acc);
            }
            ssq += __shfl_xor(ssq, 16); ssq += __shfl_xor(ssq, 32);
            const float rs = rsqrtf(ssq * (1.0f / 128.0f) + EPS);
#pragma unroll
            for (int dvb = 0; dvb < 8; ++dvb) {
                const int dv = 16 * dvb + 4 * fq;
                const float g0 = bflo(gw[dvb].x), g1 = bfhi(gw[dvb].x), g2 = bflo(gw[dvb].y), g3 = bfhi(gw[dvb].y);
                u32x2 w; w.x = pk2(o[dvb][0] * rs * pg8::silu_f(g0), o[dvb][1] * rs * pg8::silu_f(g1)); w.y = pk2(o[dvb][2] * rs * pg8::silu_f(g2), o[dvb][3] * rs * pg8::silu_f(g3));
                *(u32x2*)(MIX + tok * 1024 + h * 128 + dv) = w;
            }
        }
        __syncthreads();
    }
}
constexpr float SB_STOP = -57.7f;
__device__ __forceinline__ void sb_pair(const Args& a, int pair, LAS bf16* Vl, int lane) {
    const int fr = lane & 15, fq = lane >> 4;
    const bf16* PROJ = (const bf16*)(a.ws + WS_R0); bf16* MIX = (bf16*)(a.ws + WS_R1);
    const int bh = pair >> 8, jt = pair & 255, b = bh >> 3, h = bh & 7, t0 = 32 * jt;
    const size_t rowb = (size_t)b * T;
    bf16x8 q0[2], q1[2];
#pragma unroll
    for (int u = 0; u < 2; ++u) { const bf16* qp = PROJ + (rowb + t0 + 16 * u + fr) * NPROJ + C_QS + h * 64 + 8 * fq; q0[u] = *(const bf16x8*)qp; q1[u] = *(const bf16x8*)(qp + 32); }
    bf16x8 Tf[2];
#pragma unroll
    for (int bb = 0; bb < 2; ++bb)
#pragma unroll
        for (int jj = 0; jj < 8; ++jj) { const int j = (jj < 4) ? 4 * fq + jj : 16 + 4 * fq + (jj - 4); Tf[bb][jj] = (j > 16 * bb + fr) ? (short)0x3F80 : (short)0; }
    f32x4 o[2][4];
#pragma unroll
    for (int u = 0; u < 2; ++u)
#pragma unroll
        for (int c = 0; c < 4; ++c) o[u][c] = (f32x4){0.f, 0.f, 0.f, 0.f};
    float carry[2] = {0.f, 0.f};
    int kt0 = t0;
    const int vs = lane >> 1, vhalf = lane & 1;
    const bf16* vbase = PROJ + rowb * NPROJ + C_VS + h * 64 + 32 * vhalf;
    const bf16* kbase = PROJ + rowb * NPROJ + C_KS + h * 64 + 8 * fq;
    u32x4 vcur[4]; bf16x8 kcur[2][2];
#pragma unroll
    for (int i = 0; i < 4; ++i) vcur[i] = *(const u32x4*)(vbase + (size_t)(kt0 + vs) * NPROJ + 8 * i);
#pragma unroll
    for (int bb = 0; bb < 2; ++bb) { const bf16* kp = kbase + (size_t)(kt0 + 16 * bb + fr) * NPROJ; kcur[bb][0] = *(const bf16x8*)kp; kcur[bb][1] = *(const bf16x8*)(kp + 32); }
    for (;;) {
#pragma unroll
        for (int i = 0; i < 4; ++i)
#pragma unroll
            for (int e = 0; e < 4; ++e) { Vl[(32 * vhalf + 8 * i + 2 * e) * 36 + vs] = (bf16)(vcur[i][e] & 0xffffu); Vl[(32 * vhalf + 8 * i + 2 * e + 1) * 36 + vs] = (bf16)(vcur[i][e] >> 16); }
        f32x4 S[2][2];
#pragma unroll
        for (int u = 0; u < 2; ++u)
#pragma unroll
            for (int bb = 0; bb < 2; ++bb) { S[u][bb] = (f32x4){0.f, 0.f, 0.f, 0.f}; S[u][bb] = MFMA16(kcur[bb][0], q0[u], S[u][bb]); S[u][bb] = MFMA16(kcur[bb][1], q1[u], S[u][bb]); }
        { const int kn = kt0 >= 32 ? kt0 - 32 : 0;
#pragma unroll
          for (int i = 0; i < 4; ++i) vcur[i] = *(const u32x4*)(vbase + (size_t)(kn + vs) * NPROJ + 8 * i);
#pragma unroll
          for (int bb = 0; bb < 2; ++bb) { const bf16* kp = kbase + (size_t)(kn + 16 * bb + fr) * NPROJ; kcur[bb][0] = *(const bf16x8*)kp; kcur[bb][1] = *(const bf16x8*)(kp + 32); } }
        bf16x8 P[2]; float tot[2];
#pragma unroll
        for (int u = 0; u < 2; ++u) {
            const int t = t0 + 16 * u + fr;
            f32x4 Lm[2], lb[2]; float tt = 0.f;
#pragma unroll
            for (int bb = 0; bb < 2; ++bb)
#pragma unroll
                for (int r = 0; r < 4; ++r) { const bool ok = (kt0 + 16 * bb + 4 * fq + r) < t; const float z = S[u][bb][r];
                    const float sp = fmaxf(z, 0.f) + __builtin_amdgcn_logf(1.0f + __builtin_amdgcn_exp2f(-fabsf(z)));
                    Lm[bb][r] = ok ? -sp : 0.f; lb[bb][r] = ok ? (z - sp) : -1.0e30f; tt += Lm[bb][r]; }
            const bf16x8 Lhi = pk8(Lm[0], Lm[1]);
            f32x4 d0, d1;
            { const u32x4 w = __builtin_bit_cast(u32x4, Lhi);
              d0[0] = Lm[0][0] - bflo(w.x); d0[1] = Lm[0][1] - bfhi(w.x); d0[2] = Lm[0][2] - bflo(w.y); d0[3] = Lm[0][3] - bfhi(w.y);
              d1[0] = Lm[1][0] - bflo(w.z); d1[1] = Lm[1][1] - bfhi(w.z); d1[2] = Lm[1][2] - bflo(w.w); d1[3] = Lm[1][3] - bfhi(w.w); }
            const bf16x8 Llo = pk8(d0, d1);
            f32x4 R[2];
#pragma unroll
            for (int bb = 0; bb < 2; ++bb) { R[bb] = (f32x4){0.f, 0.f, 0.f, 0.f}; R[bb] = MFMA16(Tf[bb], Lhi, R[bb]); R[bb] = MFMA16(Tf[bb], Llo, R[bb]); }
            tt += __shfl_xor(tt, 16); tt += __shfl_xor(tt, 32);
            f32x4 pp[2];
#pragma unroll
            for (int bb = 0; bb < 2; ++bb)
#pragma unroll
                for (int r = 0; r < 4; ++r) pp[bb][r] = __builtin_amdgcn_exp2f(lb[bb][r] + R[bb][r] + carry[u]);
            P[u] = pk8(pp[0], pp[1]); tot[u] = tt;
        }
        LDS_FENCE();
#pragma unroll
        for (int c = 0; c < 4; ++c) { const LAS bf16* vrow = Vl + (16 * c + fr) * 36 + 4 * fq;
            const bf16x8 av = mk8(*(const LAS u32x2*)(vrow), *(const LAS u32x2*)(vrow + 16)); o[0][c] = MFMA16(av, P[0], o[0][c]); o[1][c] = MFMA16(av, P[1], o[1][c]); }
        LDS_FENCE();
        carry[0] += tot[0]; carry[1] += tot[1];
        if (kt0 == 0 || __all(fmaxf(carry[0], carry[1]) < SB_STOP)) break;
        kt0 -= 32;
    }
#pragma unroll
    for (int u = 0; u < 2; ++u) {
        float ssq = 0.f;
#pragma unroll
        for (int c = 0; c < 4; ++c) ssq += pg8::dot4(o[u][c]);
        ssq += __shfl_xor(ssq, 16); ssq += __shfl_xor(ssq, 32);
        const float rs = rsqrtf(ssq * (1.0f / 64.0f) + EPS);
#pragma unroll
        for (int c = 0; c < 4; ++c) { const int dv = 16 * c + 4 * fq;
            u32x2 w; w.x = pk2(o[u][c][0] * rs, o[u][c][1] * rs); w.y = pk2(o[u][c][2] * rs, o[u][c][3] * rs);
            *(u32x2*)(MIX + (rowb + t0 + 16 * u + fr) * 1024 + 512 + h * 64 + dv) = w; }
    }
}

constexpr int XPK = 272, XPV = 260;
__device__ __forceinline__ void xattn_unit(const Args& a, LAS unsigned char* lds, int unit) {
    const int tid = threadIdx.x, wid = tid >> 6, lane = tid & 63, fr = lane & 15, fq = lane >> 4;
    const bf16* KV = (const bf16*)(a.ws + WS_KV); const float* SSQK = (const float*)(a.ws + WS_SSQK); const float* SSQQ = (const float*)(a.ws + WS_SSQQ);
    const bf16* Q = (const bf16*)(a.ws + WS_R1); bf16* XO = (bf16*)(a.ws + WS_R3);
    const int tile = unit >> 2, h = unit & 3, b = tile >> 5;
    const size_t row0 = (size_t)tile * 256;
    LAS bf16* IM = (LAS bf16*)lds;
    {
        const int m = tid >> 1, half = tid & 1; const size_t kr = (size_t)(b * MEML + m);
        const f32x4 pq = *(const f32x4*)(SSQK + kr * 16 + h * 4);
        const float rk = rsqrtf(pg8::hsum4(pq) * (1.0f / 256.0f) + EPS) * 0.0625f;
        const bf16* kp = KV + kr * 2048 + h * 256 + 128 * half;
#pragma unroll
        for (int i = 0; i < 16; ++i) { const int d = 128 * half + 8 * i; const u32x4 w = *(const u32x4*)(kp + 8 * i);
            u32x4 o; o.x = pk2(bflo(w.x) * rk, bfhi(w.x) * rk); o.y = pk2(bflo(w.y) * rk, bfhi(w.y) * rk);
            o.z = pk2(bflo(w.z) * rk, bfhi(w.z) * rk); o.w = pk2(bflo(w.w) * rk, bfhi(w.w) * rk);
            *(LAS u32x4*)(IM + m * XPK + d) = o; }
    }
    __syncthreads();
    bf16x8 Pf[2][8];
#pragma unroll
    for (int qb = 0; qb < 2; ++qb) {
        const size_t tok = row0 + 32 * wid + 16 * qb + fr;
        bf16x8 Qf[8];
#pragma unroll
        for (int ks = 0; ks < 8; ++ks) Qf[ks] = *(const bf16x8*)(Q + tok * 1024 + h * 256 + 32 * ks + 8 * fq);
        const f32x4 pq = *(const f32x4*)(SSQQ + tok * 16 + h * 4);
        const float rq = rsqrtf(pg8::hsum4(pq) * (1.0f / 256.0f) + EPS);
        f32x4 S[16]; float mx = -3.0e38f;
#pragma unroll
        for (int mb = 0; mb < 16; ++mb) { f32x4 acc = {0.f, 0.f, 0.f, 0.f};
#pragma unroll
            for (int ks = 0; ks < 8; ++ks) { const bf16x8 kf = *(const LAS bf16x8*)(IM + (16 * mb + fr) * XPK + 32 * ks + 8 * fq); acc = MFMA16(kf, Qf[ks], acc); }
            acc = acc * rq; S[mb] = acc; mx = fmaxf(mx, fmaxf(fmaxf(acc[0], acc[1]), fmaxf(acc[2], acc[3]))); }
        mx = fmaxf(mx, __shfl_xor(mx, 16)); mx = fmaxf(mx, __shfl_xor(mx, 32));
        float sum = 0.f;
#pragma unroll
        for (int mb = 0; mb < 16; ++mb) {
#pragma unroll
            for (int r = 0; r < 4; ++r) { const float e = __expf(S[mb][r] - mx); S[mb][r] = e; sum += e; } }
        sum += __shfl_xor(sum, 16); sum += __shfl_xor(sum, 32);
        const float inv = 1.0f / sum;
#pragma unroll
        for (int kp = 0; kp < 8; ++kp) Pf[qb][kp] = pk8(S[2 * kp] * inv, S[2 * kp + 1] * inv);
        __builtin_amdgcn_sched_barrier(0);
    }
    __syncthreads();
    {
        const int m = tid >> 1, half = tid & 1; const bf16* vp = KV + (size_t)(b * MEML + m) * 2048 + 1024 + h * 256 + 128 * half;
#pragma unroll
        for (int i = 0; i < 16; ++i) { const u32x4 w = *(const u32x4*)(vp + 8 * i); const int dv = 128 * half + 8 * i;
#pragma unroll
            for (int e = 0; e < 4; ++e) { IM[(dv + 2 * e) * XPV + m] = (bf16)(w[e] & 0xffffu); IM[(dv + 2 * e + 1) * XPV + m] = (bf16)(w[e] >> 16); } }
    }
    __syncthreads();
    {
        const size_t tok0 = row0 + 32 * wid + fr, tok1 = tok0 + 16;
#pragma unroll
        for (int dvb = 0; dvb < 16; ++dvb) { f32x4 acc0 = {0.f, 0.f, 0.f, 0.f}, acc1 = {0.f, 0.f, 0.f, 0.f};
            const LAS bf16* vrow = IM + (16 * dvb + fr) * XPV + 4 * fq;
#pragma unroll
            for (int kp = 0; kp < 8; ++kp) { const bf16x8 av = mk8(*(const LAS u32x2*)(vrow + 32 * kp), *(const LAS u32x2*)(vrow + 32 * kp + 16)); acc0 = MFMA16(av, Pf[0][kp], acc0); acc1 = MFMA16(av, Pf[1][kp], acc1); }
            u32x2 w; w.x = pk2(acc0[0], acc0[1]); w.y = pk2(acc0[2], acc0[3]);
            *(u32x2*)(XO + tok0 * 1024 + h * 256 + 16 * dvb + 4 * fq) = w;
            w.x = pk2(acc1[0], acc1[1]); w.y = pk2(acc1[2], acc1[3]);
            *(u32x2*)(XO + tok1 * 1024 + h * 256 + 16 * dvb + 4 * fq) = w; __builtin_amdgcn_sched_barrier(0); }
    }
    __syncthreads();
}

__global__ void __launch_bounds__(NTHR, 2) hybrid_fwd(Args a) {
    extern __shared__ __attribute__((aligned(16))) unsigned char lds_raw[];
    LAS unsigned char* lds = (LAS unsigned char*)lds_raw;
    cg::grid_group grid = cg::this_grid();
    volatile LAS unsigned* bst = (volatile LAS unsigned*)(lds + 146688);
    if (threadIdx.x < 2) bst[threadIdx.x] = 0u;
    __syncthreads();
    XcdBarrier bar = xcd_barrier_post((unsigned*)(a.ws + WS_CTL), bst);
#define GRID_SYNC() do { xcd_barrier(bar); } while (0)
    if (a.ws == nullptr) grid.sync();
    const int tid = threadIdx.x, wid = __builtin_amdgcn_readfirstlane(tid >> 6), lane = tid & 63, G = gridDim.x;
    unsigned char* ws = a.ws;
    bf16* PROJ = (bf16*)(ws + WS_R0); bf16* R1 = (bf16*)(ws + WS_R1); bf16* R2 = (bf16*)(ws + WS_R2);

    p0_prologue(a, lds, wid, lane, G);
    GRID_SYNC();
    {
        pg8::Gemm g{R2, (const bf16*)(ws + WS_WIN), M, NPROJ, D}; pg8::StaticOrder S; S.init(M, NPROJ, G, (int)blockIdx.x);
        pg8::EpiScale<0> E{PROJ, NPROJ, (const float*)(ws + WS_RS0), a.b_gk, nullptr, nullptr};
        pg8::gemm_phase<pg8::EpiScale<0>, pg8::StaticOrder, true, true>(lds, g, S, E);
    }
    {
        pg8::Gemm g{(const bf16*)(ws + WS_MEMB), (const bf16*)(ws + WS_WMKV), MROWS, 2048, D}; pg8::StaticOrder S; S.init(MROWS, 2048, G, (int)((blockIdx.x + G / 2) % G));
        pg8::EpiScale<1> E{(bf16*)(ws + WS_KV), 2048, (const float*)(ws + WS_RSM), nullptr, (float*)(ws + WS_SSQK), nullptr};
        pg8::gemm_phase<pg8::EpiScale<1>, pg8::StaticOrder, true, true>(lds, g, S, E);
    }
    GRID_SYNC();
    gla_pass_a_all(a, lds, G);
    GRID_SYNC();
    {
        LAS unsigned* qctr = (LAS unsigned*)(lds + 146696);
        if (tid == 0) *qctr = 0u;
        __syncthreads();
        if (wid < 4) gla_scan_w(a, G, tid);
        for (;;) {
            unsigned idx = 0;
            if (lane == 0) idx = __hip_atomic_fetch_add(qctr, 1u, __ATOMIC_RELAXED, __HIP_MEMORY_SCOPE_WORKGROUP);
            idx = (unsigned)__builtin_amdgcn_readfirstlane((int)idx);
            const unsigned pr = (G == 256) ? (unsigned)blockIdx.x * 32u + idx : (unsigned)blockIdx.x + idx * (unsigned)G;
            if ((G == 256 && idx >= 32u) || pr >= 8192u) break;
            sb_pair(a, (int)pr, (LAS bf16*)(lds + wid * 8192), lane);
        }
    }
    GRID_SYNC();
    gla_pass_c_all(a, lds, G);
    GRID_SYNC();
    {
        pg8::Gemm g{R1, (const bf16*)(ws + WS_WOUT), M, D, D}; pg8::StaticOrder S; S.init(M, D, G, (int)blockIdx.x);
        pg8::EpiRes<0> E{a.x, nullptr, nullptr, R2, (float*)(ws + WS_SSQ1)};
        pg8::gemm_phase<pg8::EpiRes<0>, pg8::StaticOrder, true, true>(lds, g, S, E);
    }
    GRID_SYNC();
    {
        pg8::Gemm g{R2, (const bf16*)(ws + WS_WMQ), M, D, D}; pg8::StaticOrder S; S.init(M, D, G, (int)blockIdx.x);
        pg8::EpiScale<2> E{R1, D, (const float*)(ws + WS_SSQ1), a.mq_nw, (float*)(ws + WS_SSQQ), a.mk_nw};
        pg8::gemm_phase<pg8::EpiScale<2>, pg8::StaticOrder, true, true>(lds, g, S, E);
    }
    GRID_SYNC();
    for (int u = blockIdx.x; u < 512; u += G) xattn_unit(a, lds, u);
    GRID_SYNC();
    {
        pg8::Gemm g{(const bf16*)(ws + WS_R3), (const bf16*)(ws + WS_WMO), M, D, D}; pg8::StaticOrder S; S.init(M, D, G, (int)blockIdx.x);
        pg8::EpiRes<1> E{nullptr, R2, nullptr, R1, (float*)(ws + WS_SSQ2)};
        pg8::gemm_phase<pg8::EpiRes<1>, pg8::StaticOrder, true, true>(lds, g, S, E);
    }
    GRID_SYNC();
    {
        pg8::Gemm g{R1, (const bf16*)(ws + WS_WGU), M, 2 * DFF, D}; pg8::StaticOrder S; S.init(M, 2 * DFF, G, (int)blockIdx.x);
        const pg8::RstdTab RT = pg8::fill_rstd_table(S, (const float*)(ws + WS_SSQ2), (LAS float*)(lds + 131072));
        pg8::EpiGateUp E{PROJ, (const float*)(ws + WS_SSQ2), RT};
        pg8::gemm_phase<pg8::EpiGateUp, pg8::StaticOrder, true, true>(lds, g, S, E);
    }
    GRID_SYNC();
    {
        pg8::Gemm g{PROJ, (const bf16*)(ws + WS_WDN), M, D, DFF}; pg8::StaticOrder S; S.init(M, D, G, (int)blockIdx.x);
        pg8::EpiRes<2> E{nullptr, R1, a.out, nullptr, nullptr};
        pg8::gemm_phase<pg8::EpiRes<2>, pg8::StaticOrder, true, true>(lds, g, S, E);
    }
}

extern "C" void kernel_launch(void* const* d_in, const int* in_sizes, int n_in, void* d_out, int out_size, void* d_ws, size_t ws_size, hipStream_t stream) {
    static int grid = 0;
    if (grid == 0) {
        if (n_in != 19 || in_sizes[0] != M * D || out_size != M * D || ws_size < WS_END) { fprintf(stderr, "kernel_launch: unexpected shapes (n_in %d, ws %zu)\n", n_in, ws_size); grid = -1; return; }
        int dev = 0, cus = 0, per_cu = 0;
        if (hipGetDevice(&dev) != hipSuccess || hipDeviceGetAttribute(&cus, hipDeviceAttributeMultiprocessorCount, dev) != hipSuccess) { grid = -1; return; }
        if (hipFuncSetAttribute((const void*)hybrid_fwd, hipFuncAttributeMaxDynamicSharedMemorySize, LDS_BYTES) != hipSuccess) { fprintf(stderr, "kernel_launch: hipFuncSetAttribute failed\n"); grid = -1; return; }
        if (hipOccupancyMaxActiveBlocksPerMultiprocessor(&per_cu, (const void*)hybrid_fwd, NTHR, LDS_BYTES) != hipSuccess || per_cu < 1) { fprintf(stderr, "kernel_launch: occupancy query says %d\n", per_cu); per_cu = 1; }
        (void)hipGetLastError();
        grid = cus;
    }
    if (grid < 0) return;
    if (hipMemsetAsync((char*)d_ws + WS_CTL, 0, 16384, stream) != hipSuccess) { fprintf(stderr, "kernel_launch: memset failed\n"); return; }
    Args a{};
    a.x = (const float*)d_in[0]; a.mem = (const float*)d_in[1]; a.mix_nw = (const float*)d_in[2]; a.w_in = (const float*)d_in[3]; a.w_gk_up = (const float*)d_in[4]; a.b_gk = (const float*)d_in[5];
    a.gla_nw = (const float*)d_in[6]; a.sb_nw = (const float*)d_in[7]; a.w_out = (const float*)d_in[8]; a.xat_nw = (const float*)d_in[9]; a.mem_nw = (const float*)d_in[10]; a.w_mq = (const float*)d_in[11];
    a.w_mkv = (const float*)d_in[12]; a.mq_nw = (const float*)d_in[13]; a.mk_nw = (const float*)d_in[14]; a.w_mo = (const float*)d_in[15]; a.ffn_nw = (const float*)d_in[16]; a.w_gu = (const float*)d_in[17]; a.w_dn = (const float*)d_in[18];
    a.out = (float*)d_out; a.ws = (unsigned char*)d_ws;
    void* args[] = {&a};
    hipError_t e = hipLaunchCooperativeKernel((const void*)hybrid_fwd, dim3(grid), dim3(NTHR), args, LDS_BYTES, stream);
    if (e != hipSuccess) fprintf(stderr, "kernel_launch: cooperative launch failed: %s (grid %d)\n", hipGetErrorString(e), grid);
}
```

```cpp
#include <hip/hip_runtime.h>
#include <hip/hip_cooperative_groups.h>
#include <cstdio>
#include <cstdint>
namespace cg = cooperative_groups;
namespace pg8 {
#define PG8_LAS __attribute__((address_space(3)))
typedef unsigned short bf16_t;
typedef short bf16x8 __attribute__((ext_vector_type(8)));
typedef float f32x4 __attribute__((ext_vector_type(4)));
typedef unsigned u32x4 __attribute__((ext_vector_type(4)));
constexpr int BM = 256, BK = 64, HALF = 128, HTB = HALF * BK * 2  , STAGE_BYTES = 8 * HTB, NXCD = 8, WGM = 8;

__host__ __device__ __forceinline__ int lds_byte(int r, int c) { const int st = (r >> 4) * 2 + (c >> 5), rr = r & 15, cc = c & 31, ob = rr * 64 + cc * 2; return st * 1024 + (ob ^ (((ob >> 9) & 1) << 5)); }
__host__ __device__ __forceinline__ void stage_rc(int b, int& R, int& C) { const int st = b / 1024, sb = b % 1024, swz = sb ^ (((sb >> 9) & 1) << 5); R = (st >> 1) * 16 + swz / 64; C = (st & 1) * 32 + (swz % 64) / 2; }
__host__ __device__ __forceinline__ int perm32(int rho) { const int n = rho >> 4, i = rho & 15; return 8 * (i >> 2) + 4 * n + (i & 3); }

struct Unit { int pm, pn; };
struct Gemm { const bf16_t* A; const bf16_t* Bt; int M, N, K; };

struct StaticOrder {
    int nM, nN, nwg, G, c;
    __host__ __device__ void init(int M, int N, int G_, int c_) { nM = M / BM; nN = N / BM; nwg = nM * nN; G = G_; c = c_; }
    __host__ __device__ bool next(int i, Unit& u) const {
        const long L = (long)i * G + c; if (L >= nwg) return false;
        int wgid = (int)L; { const int q = nwg / NXCD, r = nwg % NXCD, xcd = wgid % NXCD, off = wgid / NXCD; wgid = (xcd < r ? xcd * (q + 1) : r * (q + 1) + (xcd - r) * q) + off; }
        const int nig = WGM * nN, gid = wgid / nig, fm = gid * WGM, gsz = (nM - fm) < WGM ? (nM - fm) : WGM;
        u.pm = fm + ((wgid % nig) % gsz); u.pn = (wgid % nig) / gsz; return true;
    }
    __device__ __forceinline__ void a_ready(const Unit&) const {}
    __device__ __forceinline__ void done(const Unit&) const {}
};

__device__ __forceinline__ unsigned cvt_pk_bf16(float lo, float hi) { unsigned r; asm volatile("v_cvt_pk_bf16_f32 %0, %1, %2" : "=v"(r) : "v"(lo), "v"(hi)); return r; }
typedef float f32x2 __attribute__((ext_vector_type(2)));
typedef unsigned u32x2 __attribute__((ext_vector_type(2)));
__device__ __forceinline__ float hsum4(const f32x4 v) { return (v[0] + v[1]) + (v[2] + v[3]); }
__device__ __forceinline__ float dot4(const f32x4 v) { return (v[0] * v[0] + v[1] * v[1]) + (v[2] * v[2] + v[3] * v[3]); }
__device__ __forceinline__ float row_rstd16(const float* ssq, int row, float inv_n, float eps) {
    const f32x4* p = (const f32x4*)(ssq + (size_t)row * 16);
    const f32x4 a = p[0], b = p[1], c = p[2], d = p[3];
    return rsqrtf(((hsum4(a) + hsum4(b)) + (hsum4(c) + hsum4(d))) * inv_n + eps);
}
__device__ __forceinline__ float logsig_f(float v) { return fminf(v, 0.f) - __logf(1.0f + __expf(-fabsf(v))); }
__device__ __forceinline__ float silu_f(float g) { return g * __builtin_amdgcn_rcpf(1.0f + __expf(-g)); }
__device__ __forceinline__ u32x4 pack8(const f32x4 v0, const f32x4 v1) { u32x4 w; w.x = cvt_pk_bf16(v0[0], v0[1]); w.y = cvt_pk_bf16(v0[2], v0[3]); w.z = cvt_pk_bf16(v1[0], v1[1]); w.w = cvt_pk_bf16(v1[2], v1[3]); return w; }
template <int MODE> struct EpiScale {
    static constexpr bool PERM = true, AFTER_DRAIN = false;
    bf16_t* O; int ldc; const float* rs; const float* bias; float* ssq_out; const float* bias2;
    __device__ __forceinline__ void operator()(const f32x4 (&acc)[2][2][4][2], const Unit& u, int wr, int wc, int fr, int fq) const {
        const int row0 = u.pm * BM + wr * 64 + fr, col0 = u.pn * BM + wc * 32 + 8 * fq;
        const bool gk = (MODE == 0) && (u.pn == 6);
        f32x4 bv[2][2];
#pragma unroll
        for (int bj = 0; bj < 2; ++bj)
#pragma unroll
            for (int n = 0; n < 2; ++n) { if (MODE == 2) { const int cd = wc * 32 + 8 * fq + bj * HALF + 4 * n; bv[bj][n] = *(const f32x4*)(bias + cd) * *(const f32x4*)(bias2 + cd); }
                else bv[bj][n] = gk ? *(const f32x4*)(bias + (col0 - 1536) + bj * HALF + 4 * n) : (f32x4){0.f, 0.f, 0.f, 0.f}; }
        float sc8[2][4];
        if (MODE != 2) {
#pragma unroll
            for (int ai = 0; ai < 2; ++ai)
#pragma unroll
                for (int m = 0; m < 4; ++m) sc8[ai][m] = rs[row0 + ai * HALF + m * 16];
            asm volatile("" ::: "memory");
        }
#pragma unroll
        for (int ai = 0; ai < 2; ++ai)
#pragma unroll
            for (int m = 0; m < 4; ++m) {
                const int row = row0 + ai * HALF + m * 16;
                const float s = (MODE == 2) ? row_rstd16(rs, row, 1.0f / 1024.0f, 1e-6f) : sc8[ai][m];
                float q = 0.f;
#pragma unroll
                for (int bj = 0; bj < 2; ++bj) {
                    f32x4 v0 = acc[ai][bj][m][0] * s, v1 = acc[ai][bj][m][1] * s;
                    if (MODE == 0) { if (gk) {
#pragma unroll
                        for (int e = 0; e < 4; ++e) { v0[e] = logsig_f(v0[e] + bv[bj][0][e]) * 0.0625f; v1[e] = logsig_f(v1[e] + bv[bj][1][e]) * 0.0625f; } } }
                    if (MODE != 0) q += dot4(v0) + dot4(v1);
                    if (MODE == 2) { v0 = v0 * bv[bj][0]; v1 = v1 * bv[bj][1]; }
                    *(u32x4*)(O + (size_t)row * ldc + col0 + bj * HALF) = pack8(v0, v1);
                }
                if (MODE != 0) { q += __shfl_xor(q, 16); q += __shfl_xor(q, 32); if (fq == 0 && (MODE == 2 || u.pn < 4)) ssq_out[(size_t)row * 16 + u.pn * 4 + wc] = q; }
            }
    }
};
#ifndef RES_ROWS_BF16
#define RES_ROWS_BF16 4
#endif
template <int RES> struct EpiRes {
    static constexpr bool PERM = true, AFTER_DRAIN = false;
    static constexpr int RB = (RES == 0) ? 2 : RES_ROWS_BF16;
    const float* resid_f; const bf16_t* resid_b; float* out_f; bf16_t* out_b; float* ssq_out;
    __device__ __forceinline__ void operator()(const f32x4 (&acc)[2][2][4][2], const Unit& u, int wr, int wc, int fr, int fq) const {
        const int row0 = u.pm * BM + wr * 64 + fr, col0 = u.pn * BM + wc * 32 + 8 * fq;
#pragma unroll
        for (int g2 = 0; g2 < 8 / RB; ++g2) {
            f32x4 rf[RES == 0 ? RB : 1][2][2]; u32x4 rb[RES == 0 ? 1 : RB][2];
#pragma unroll
            for (int mm = 0; mm < RB; ++mm)
#pragma unroll
                for (int bj = 0; bj < 2; ++bj) { const int rr = g2 * RB + mm; const size_t off = (size_t)(row0 + (rr >> 2) * HALF + (rr & 3) * 16) * 1024 + col0 + bj * HALF;
                    if (RES == 0) { rf[mm][bj][0] = *(const f32x4*)(resid_f + off); rf[mm][bj][1] = *(const f32x4*)(resid_f + off + 4); } else rb[mm][bj] = *(const u32x4*)(resid_b + off); }
            asm volatile("" ::: "memory");
#pragma unroll
            for (int mm = 0; mm < RB; ++mm) {
                const int rr = g2 * RB + mm, ai = rr >> 2, m = rr & 3;
                const int row = row0 + ai * HALF + m * 16; float q = 0.f;
#pragma unroll
                for (int bj = 0; bj < 2; ++bj) {
                    const size_t off = (size_t)row * 1024 + col0 + bj * HALF;
                    f32x4 r0, r1;
                    if (RES == 0) { r0 = rf[mm][bj][0]; r1 = rf[mm][bj][1]; }
                    else { const u32x4 w = rb[mm][bj];
                        r0[0] = __builtin_bit_cast(float, w.x << 16); r0[1] = __builtin_bit_cast(float, w.x & 0xffff0000u); r0[2] = __builtin_bit_cast(float, w.y << 16); r0[3] = __builtin_bit_cast(float, w.y & 0xffff0000u);
                        r1[0] = __builtin_bit_cast(float, w.z << 16); r1[1] = __builtin_bit_cast(float, w.z & 0xffff0000u); r1[2] = __builtin_bit_cast(float, w.w << 16); r1[3] = __builtin_bit_cast(float, w.w & 0xffff0000u); }
                    const f32x4 v0 = acc[ai][bj][m][0] + r0, v1 = acc[ai][bj][m][1] + r1;
                    if (RES == 2) { __builtin_nontemporal_store(v0, (f32x4*)(out_f + off)); __builtin_nontemporal_store(v1, (f32x4*)(out_f + off + 4)); }
                    else { q += dot4(v0) + dot4(v1); *(u32x4*)(out_b + off) = pack8(v0, v1); }
                }
                if (RES != 2) { q += __shfl_xor(q, 16); q += __shfl_xor(q, 32); if (fq == 0) ssq_out[(size_t)row * 16 + u.pn * 4 + wc] = q; }
            }
        }
    }
};
struct RstdTab { const PG8_LAS float* tab; int p0, p1, p2, p3; };
template <class Sched> __device__ __forceinline__ RstdTab fill_rstd_table(const Sched& S, const float* ssq, PG8_LAS float* tab) {
    RstdTab T; T.tab = tab; T.p0 = T.p1 = T.p2 = T.p3 = -1;
    Unit u;
    for (int i = 0; S.next(i, u); ++i) { const int pm = u.pm; if (pm == T.p0 || pm == T.p1 || pm == T.p2 || pm == T.p3) continue;
        if (T.p0 < 0) T.p0 = pm; else if (T.p1 < 0) T.p1 = pm; else if (T.p2 < 0) T.p2 = pm; else if (T.p3 < 0) T.p3 = pm; }
    const int tid = threadIdx.x;
#pragma unroll
    for (int s2 = 0; s2 < 4; s2 += 2) { const int s = s2 + (tid >> 8); const int pm = (s == 0) ? T.p0 : (s == 1) ? T.p1 : (s == 2) ? T.p2 : T.p3;
        if (pm >= 0) tab[s * 256 + (tid & 255)] = row_rstd16(ssq, pm * BM + (tid & 255), 1.0f / 1024.0f, 1e-6f); }
    __syncthreads();
    return T;
}
__device__ __forceinline__ int rstd_slot(const RstdTab& T, int pm) { return (pm == T.p0) ? 0 : (pm == T.p1) ? 1 : (pm == T.p2) ? 2 : (pm == T.p3) ? 3 : -1; }
struct EpiGateUp {
    static constexpr bool PERM = true, AFTER_DRAIN = false;
    bf16_t* H; const float* ssq; RstdTab T;
    __device__ __forceinline__ void operator()(const f32x4 (&acc)[2][2][4][2], const Unit& u, int wr, int wc, int fr, int fq) const {
        const int row0 = u.pm * BM + wr * 64 + fr, col0 = u.pn * HALF + wc * 32 + 8 * fq;
        const int slot = rstd_slot(T, u.pm);
        float sc[2][4];
#pragma unroll
        for (int ai = 0; ai < 2; ++ai)
#pragma unroll
            for (int m = 0; m < 4; ++m) { const int rl = wr * 64 + fr + ai * HALF + m * 16;
                sc[ai][m] = (slot >= 0) ? T.tab[slot * 256 + rl] : row_rstd16(ssq, u.pm * BM + rl, 1.0f / 1024.0f, 1e-6f); }
#pragma unroll
        for (int ai = 0; ai < 2; ++ai)
#pragma unroll
            for (int m = 0; m < 4; ++m) {
                const int row = row0 + ai * HALF + m * 16;
                const float s = sc[ai][m];
                f32x4 h0, h1;
#pragma unroll
                for (int e = 0; e < 4; ++e) { h0[e] = silu_f(acc[ai][0][m][0][e] * s) * (acc[ai][1][m][0][e] * s); h1[e] = silu_f(acc[ai][0][m][1][e] * s) * (acc[ai][1][m][1][e] * s); }
                *(u32x4*)(H + (size_t)row * 2816 + col0) = pack8(h0, h1);
            }
    }
};
template <class Epi, class Sched, bool ALIGN_EPI = false, bool SP2 = false>
__device__ __forceinline__ void gemm_phase(PG8_LAS unsigned char* lds, const Gemm g, const Sched& S, const Epi& E) {
    const int tid = threadIdx.x, wid = __builtin_amdgcn_readfirstlane(tid >> 6), lane = tid & 63, wr = wid >> 2, wc = wid & 3, fr = lane & 15, fq = lane >> 4;
    const int K = g.K, nt = K / BK;
    unsigned voffA[2], voffB[2];
#pragma unroll
    for (int i = 0; i < 2; ++i) { int R, C; stage_rc(tid * 16 + i * 8192, R, C); const int Rb = Epi::PERM ? ((R & ~31) + perm32(R & 31)) : R;
        voffA[i] = (unsigned)(R * K + C) * 2u; voffB[i] = (unsigned)(Rb * K + C) * 2u; }
    const size_t kstep = (size_t)(BK * 2);
    const size_t hstep = (size_t)HALF * K * 2;
    const size_t tstep = 2 * hstep;
    const unsigned ldsw = (unsigned)wid * 1024u;
    const int aoff = lds_byte(wr * 64 + fr, fq * 8), boff = lds_byte(wc * 32 + fr, fq * 8);
#define PG8_SA(b, h) (((b) * 2 + (h)) * HTB)
#define PG8_SB(b, h) ((4 + (b) * 2 + (h)) * HTB)
#define PG8_STAGE(bufoff, gbase, voff) do { _Pragma("unroll") for (int _i = 0; _i < 2; ++_i) \
        __builtin_amdgcn_global_load_lds((const unsigned*)((const char*)(gbase) + (voff)[_i]), (PG8_LAS unsigned*)(lds + (bufoff) + ldsw + _i * 8192), 16, 0, 0); } while (0)
#define PG8_LDA(dst, b, h) do { _Pragma("unroll") for (int m = 0; m < 4; ++m) _Pragma("unroll") for (int k = 0; k < 2; ++k) dst[m][k] = *(const PG8_LAS bf16x8*)(lds + PG8_SA(b, h) + aoff + m * 2048 + k * 1024); } while (0)
#define PG8_LDB(dst, b, h) do { _Pragma("unroll") for (int n = 0; n < 2; ++n) _Pragma("unroll") for (int k = 0; k < 2; ++k) dst[n][k] = *(const PG8_LAS bf16x8*)(lds + PG8_SB(b, h) + boff + n * 2048 + k * 1024); } while (0)
#define PG8_MMA(ai, bj, At, Bt) do { __builtin_amdgcn_s_setprio(1); _Pragma("unroll") for (int m = 0; m < 4; ++m) _Pragma("unroll") for (int n = 0; n < 2; ++n) _Pragma("unroll") for (int k = 0; k < 2; ++k) \
        acc[ai][bj][m][n] = __builtin_amdgcn_mfma_f32_16x16x32_bf16(Bt[n][k], At[m][k], acc[ai][bj][m][n], 0, 0, 0); __builtin_amdgcn_s_setprio(0); } while (0)
#define PG8_WAIT_V(n) asm volatile("s_waitcnt vmcnt(" #n ")" ::: "memory")
#define PG8_WAIT_L(n) asm volatile("s_waitcnt lgkmcnt(" #n ")" ::: "memory")
#define PG8_BAR __builtin_amdgcn_s_barrier()
#define PG8_SCHED __builtin_amdgcn_sched_barrier(0)
    Unit cur, nxt; int ui = 0;
    if (!S.next(0, cur)) return;
    f32x4 acc[2][2][4][2];
#pragma unroll
    for (int a = 0; a < 2; ++a)
#pragma unroll
        for (int b = 0; b < 2; ++b)
#pragma unroll
            for (int m = 0; m < 4; ++m)
#pragma unroll
                for (int n = 0; n < 2; ++n) acc[a][b][m][n] = (f32x4){0.f, 0.f, 0.f, 0.f};
    bf16x8 At[4][2], B0[2][2], B1[2][2];
    const char* cA = (const char*)g.A + (size_t)cur.pm * tstep; const char* cB = (const char*)g.Bt + (size_t)cur.pn * tstep;
    S.a_ready(cur);
    if constexpr (SP2) {
        PG8_STAGE(PG8_SB(0, 0), cB, voffB); PG8_STAGE(PG8_SB(0, 1), cB + hstep, voffB); PG8_STAGE(PG8_SA(0, 0), cA, voffA); PG8_STAGE(PG8_SA(0, 1), cA + hstep, voffA);
        if (wr == 1) PG8_BAR;
        PG8_WAIT_V(2); PG8_BAR;
        PG8_STAGE(PG8_SB(1, 0), cB + kstep, voffB); PG8_STAGE(PG8_SA(1, 0), cA + kstep, voffA); PG8_STAGE(PG8_SB(1, 1), cB + hstep + kstep, voffB);
        PG8_WAIT_V(6); PG8_BAR;
    } else {
        PG8_STAGE(PG8_SB(0, 0), cB, voffB); PG8_STAGE(PG8_SA(0, 0), cA, voffA); PG8_STAGE(PG8_SB(0, 1), cB + hstep, voffB); PG8_STAGE(PG8_SA(0, 1), cA + hstep, voffA);
        if (wr == 1) PG8_BAR;
        PG8_WAIT_V(4); PG8_BAR;
        PG8_STAGE(PG8_SB(1, 0), cB + kstep, voffB); PG8_STAGE(PG8_SA(1, 0), cA + kstep, voffA); PG8_STAGE(PG8_SB(1, 1), cB + hstep + kstep, voffB);
        PG8_WAIT_V(6); PG8_BAR;
    }
    for (;;) {
        const bool has_next = S.next(ui + 1, nxt);
        const char* nA = has_next ? (const char*)g.A + (size_t)nxt.pm * tstep : cA; const char* nB = has_next ? (const char*)g.Bt + (size_t)nxt.pn * tstep : cB;
        for (int t = 0; t < nt; t += 2) {
            const bool last = (t == nt - 2);
            const char* a1 = cA + (size_t)(t + 1) * kstep;
            const char* a2 = last ? nA : cA + (size_t)(t + 2) * kstep; const char* b2 = last ? nB : cB + (size_t)(t + 2) * kstep;
            const char* a3 = a2 + kstep; const char* b3 = b2 + kstep;
            if (last && has_next) S.a_ready(nxt);
            if constexpr (SP2) {
            PG8_LDB(B0, 0, 0); PG8_LDB(B1, 0, 1); PG8_SCHED; PG8_LDA(At, 0, 0); PG8_STAGE(PG8_SA(1, 1), a1 + hstep, voffA);
            PG8_WAIT_V(8); PG8_WAIT_L(0); PG8_BAR; PG8_MMA(0, 0, At, B0); PG8_MMA(0, 1, At, B1); PG8_BAR; PG8_SCHED;
            PG8_LDA(At, 0, 1); PG8_STAGE(PG8_SB(0, 0), b2, voffB); PG8_STAGE(PG8_SB(0, 1), b2 + hstep, voffB); PG8_STAGE(PG8_SA(0, 0), a2, voffA);
            PG8_WAIT_V(8); PG8_WAIT_L(0); PG8_BAR; PG8_MMA(1, 0, At, B0); PG8_MMA(1, 1, At, B1); PG8_BAR; PG8_SCHED;
            PG8_LDB(B0, 1, 0); PG8_LDB(B1, 1, 1); PG8_SCHED; PG8_LDA(At, 1, 0); PG8_STAGE(PG8_SA(0, 1), a2 + hstep, voffA);
            PG8_WAIT_V(8); PG8_WAIT_L(0); PG8_BAR; PG8_MMA(0, 0, At, B0); PG8_MMA(0, 1, At, B1); PG8_BAR; PG8_SCHED;
            PG8_LDA(At, 1, 1); PG8_STAGE(PG8_SB(1, 0), b3, voffB); PG8_STAGE(PG8_SB(1, 1), b3 + hstep, voffB); PG8_STAGE(PG8_SA(1, 0), a3, voffA);
            PG8_WAIT_V(8); PG8_WAIT_L(0); PG8_BAR; PG8_MMA(1, 0, At, B0); PG8_MMA(1, 1, At, B1); PG8_BAR; PG8_SCHED;
            } else {
            PG8_LDB(B0, 0, 0); PG8_SCHED; PG8_LDA(At, 0, 0); PG8_STAGE(PG8_SA(1, 1), a1 + hstep, voffA);
            PG8_WAIT_L(8); PG8_BAR; PG8_WAIT_L(0); PG8_MMA(0, 0, At, B0); PG8_BAR; PG8_SCHED;
            PG8_LDB(B1, 0, 1); PG8_STAGE(PG8_SB(0, 0), b2, voffB);
            PG8_BAR; PG8_WAIT_L(0); PG8_MMA(0, 1, At, B1); PG8_BAR;
            PG8_LDA(At, 0, 1); PG8_STAGE(PG8_SA(0, 0), a2, voffA);
            PG8_BAR; PG8_WAIT_L(0); PG8_MMA(1, 0, At, B0); PG8_BAR; PG8_SCHED;
            PG8_STAGE(PG8_SB(0, 1), b2 + hstep, voffB);
            PG8_WAIT_V(6); PG8_BAR; PG8_MMA(1, 1, At, B1); PG8_BAR;
            PG8_LDB(B0, 1, 0); PG8_SCHED; PG8_LDA(At, 1, 0); PG8_STAGE(PG8_SA(0, 1), a2 + hstep, voffA);
            PG8_WAIT_L(8); PG8_BAR; PG8_WAIT_L(0); PG8_MMA(0, 0, At, B0); PG8_BAR; PG8_SCHED;
            PG8_LDB(B1, 1, 1); PG8_STAGE(PG8_SB(1, 0), b3, voffB);
            PG8_BAR; PG8_WAIT_L(0); PG8_MMA(0, 1, At, B1); PG8_BAR;
            PG8_LDA(At, 1, 1); PG8_STAGE(PG8_SA(1, 0), a3, voffA);
            PG8_BAR; PG8_WAIT_L(0); PG8_MMA(1, 0, At, B0); PG8_BAR; PG8_SCHED;
            PG8_STAGE(PG8_SB(1, 1), b3 + hstep, voffB);
            PG8_WAIT_V(6); PG8_BAR; PG8_MMA(1, 1, At, B1); PG8_BAR;
            }
        }
        if constexpr (ALIGN_EPI) { if (wr == 0) PG8_BAR; }
        if constexpr (!Epi::AFTER_DRAIN) { E(acc, cur, wr, wc, fr, fq); S.done(cur); }
        if (!has_next) break;
#pragma unroll
        for (int a = 0; a < 2; ++a)
#pragma unroll
            for (int b = 0; b < 2; ++b)
#pragma unroll
                for (int m = 0; m < 4; ++m)
#pragma unroll
                    for (int n = 0; n < 2; ++n) acc[a][b][m][n] = (f32x4){0.f, 0.f, 0.f, 0.f};
        cur = nxt; cA = nA; cB = nB; ++ui;
        if constexpr (ALIGN_EPI) { if (wr == 1) PG8_BAR; }
    }
    PG8_WAIT_V(0);
    if constexpr (!ALIGN_EPI) { if (wr == 0) PG8_BAR; }
    PG8_BAR;
    if constexpr (Epi::AFTER_DRAIN) { E.fused(acc, cur, wr, wc, fr, fq, lds, wid, lane); S.done(cur); }
#undef PG8_SA
#undef PG8_SB
#undef PG8_STAGE
#undef PG8_LDA
#undef PG8_LDB
#undef PG8_MMA
#undef PG8_WAIT_V
#undef PG8_WAIT_L
#undef PG8_BAR
#undef PG8_SCHED
}
}
#define LAS __attribute__((address_space(3)))
typedef unsigned short bf16;
typedef unsigned u32x4 __attribute__((ext_vector_type(4)));
typedef unsigned u32x2 __attribute__((ext_vector_type(2)));
typedef float f32x4 __attribute__((ext_vector_type(4)));
typedef short bf16x8 __attribute__((ext_vector_type(8)));
typedef unsigned long long u64;

constexpr int NB = 4, T = 8192, D = 1024, M = NB * T, NPROJ = 3328, DFF = 2816, MEML = 256, MROWS = NB * MEML;
constexpr int C_QG = 0, C_KG = 256, C_VG = 512, C_GG = 1024, C_GK = 1536, C_QS = 1792, C_KS = 2304, C_VS = 2816;
constexpr float EPS = 1e-6f;
constexpr size_t MiB = 1u << 20;
constexpr size_t WS_WIN = 0, WS_WOUT = 7 * MiB, WS_WMQ = 9 * MiB, WS_WMKV = 11 * MiB, WS_WMO = 15 * MiB, WS_WGU = 17 * MiB, WS_WDN = 28 * MiB;
constexpr size_t WS_RS0 = 34 * MiB, WS_RSM = 34 * MiB + 128 * 1024, WS_SSQK = 34 * MiB + 256 * 1024, WS_SSQ1 = 35 * MiB, WS_SSQ2 = 37 * MiB, WS_SSQQ = 39 * MiB;
constexpr size_t WS_MEMB = 41 * MiB, WS_KV = 43 * MiB, WS_DEC = 47 * MiB, WS_CTL = 47 * MiB + 768 * 1024;
constexpr size_t WS_R0 = 48 * MiB, WS_R1 = 256 * MiB, WS_R2 = 320 * MiB, WS_R3 = 384 * MiB, WS_STB = 448 * MiB, WS_END = 480 * MiB;
static_assert(WS_R0 + (size_t)M * NPROJ * 2 <= WS_R1 && WS_WDN + (size_t)D * DFF * 2 <= WS_RS0, "ws map");
constexpr int LDS_BYTES = 147456;
constexpr int NTHR = 512;

__device__ __forceinline__ unsigned f2bf(float f) { unsigned u = __builtin_bit_cast(unsigned, f); return (u + 0x7fffu + ((u >> 16) & 1u)) >> 16; }
typedef float f32x2c __attribute__((ext_vector_type(2)));
typedef __bf16 bf16x2c __attribute__((ext_vector_type(2)));
__device__ __forceinline__ unsigned pk2(float lo, float hi) { const f32x2c v = {lo, hi}; const bf16x2c b = __builtin_convertvector(v, bf16x2c); return __builtin_bit_cast(unsigned, b); }
__device__ __forceinline__ float bf2f(unsigned short h) { return __builtin_bit_cast(float, (unsigned)h << 16); }
__device__ __forceinline__ float bflo(unsigned w) { return __builtin_bit_cast(float, w << 16); }
__device__ __forceinline__ float bfhi(unsigned w) { return __builtin_bit_cast(float, w & 0xffff0000u); }
__device__ __forceinline__ float wave_sum(float v) {
#pragma unroll
    for (int o = 1; o < 64; o <<= 1) v += __shfl_xor(v, o);
    return v;
}
__device__ __forceinline__ bf16x8 mk8(u32x4 w) { return __builtin_bit_cast(bf16x8, w); }
__device__ __forceinline__ bf16x8 mk8(u32x2 lo, u32x2 hi) { u32x4 w; w.x = lo.x; w.y = lo.y; w.z = hi.x; w.w = hi.y; return __builtin_bit_cast(bf16x8, w); }
__device__ __forceinline__ bf16x8 pk8(const f32x4 a, const f32x4 b) { u32x4 w; w.x = pk2(a[0], a[1]); w.y = pk2(a[2], a[3]); w.z = pk2(b[0], b[1]); w.w = pk2(b[2], b[3]); return __builtin_bit_cast(bf16x8, w); }
#define MFMA16(a, b, c) __builtin_amdgcn_mfma_f32_16x16x32_bf16((a), (b), (c), 0, 0, 0)
#define LDS_FENCE() asm volatile("s_waitcnt lgkmcnt(0)" ::: "memory")

#define XB_TMO      128
#define XB_XCNT(j)  (256  + 64 * (j))
#define XB_XSUB(j)  (1280 + 64 * (j))
#define XB_XGEN(j)  (2304 + 64 * (j))
#define XB_TOP      3328
#define XB_TOPGEN   3392
#define XCD_BAR_WORDS 3456
#define XB_SPIN_CAP (1u << 18)

__device__ __forceinline__ unsigned xb_ld(unsigned* p)              { return __hip_atomic_load(p, __ATOMIC_RELAXED, __HIP_MEMORY_SCOPE_AGENT); }
__device__ __forceinline__ unsigned xb_add(unsigned* p, unsigned v) { return __hip_atomic_fetch_add(p, v, __ATOMIC_RELAXED, __HIP_MEMORY_SCOPE_AGENT); }
__device__ __forceinline__ unsigned xb_xcc_id() { return (unsigned)__builtin_amdgcn_s_getreg((3 << 11) | 20) & 0xFu; }
#define XB_SPIN(cond, bar) do { unsigned _sp = 0; while (cond) { __builtin_amdgcn_s_sleep(1); \
    if ((++_sp & 255u) == 0u) { if (xb_ld(&(bar)[XB_TMO])) break; if (_sp > XB_SPIN_CAP) { atomicAdd(&(bar)[XB_TMO], 1u); break; } } } } while (0)

struct XcdBarrier {
    unsigned* bar; unsigned x;
    volatile LAS unsigned* st;
};

__device__ __forceinline__ XcdBarrier xcd_barrier_post(unsigned* bar, volatile LAS unsigned* st) {
    XcdBarrier b; b.bar = bar; b.x = xb_xcc_id(); b.st = st;
    if (threadIdx.x == 0) (void)xb_add(&bar[XB_XCNT(b.x)], 1u);
    return b;
}
__device__ __forceinline__ void xcd_barrier_complete(unsigned* bar, unsigned x, unsigned& nloc, unsigned& nx) {
    const unsigned G = gridDim.x * gridDim.y * gridDim.z;
    unsigned sum, cnt, mine, sp = 0u;
    for (;;) {
        sum = 0u; cnt = 0u; mine = 0u;
#pragma unroll
        for (unsigned j = 0; j < 16; ++j) { const unsigned c = xb_ld(&bar[XB_XCNT(j)]); sum += c; cnt += (c > 0u) ? 1u : 0u; mine = (j == x) ? c : mine; }
        if (sum == G) break;
        __builtin_amdgcn_s_sleep(1);
        if ((++sp & 255u) == 0u) { if (xb_ld(&bar[XB_TMO])) break; if (sp > XB_SPIN_CAP) { atomicAdd(&bar[XB_TMO], 1u); break; } }
    }
    nloc = mine > 0u ? mine : 1u; nx = cnt > 0u ? cnt : 1u;
}

__device__ __forceinline__ void xcd_barrier(const XcdBarrier& b) {
    asm volatile("s_waitcnt vmcnt(0)" ::: "memory");
    __syncthreads();
    if (threadIdx.x == 0) {
        unsigned* bar = b.bar;
        __builtin_amdgcn_s_waitcnt(0);
        unsigned nloc = b.st[0], nx = b.st[1];
        if (nloc == 0u) { xcd_barrier_complete(bar, b.x, nloc, nx); b.st[0] = nloc; b.st[1] = nx; }
        const unsigned old = xb_add(&bar[XB_XSUB(b.x)], 1u);
        const unsigned gen = old / nloc;
        if (old + 1u == (gen + 1u) * nloc) {
            __builtin_amdgcn_fence(__ATOMIC_RELEASE, "agent");
            asm volatile("s_waitcnt vmcnt(0)" ::: "memory");
            const unsigned og = xb_add(&bar[XB_TOP], 1u);
            const unsigned tg = og / nx;
            if (og + 1u == (tg + 1u) * nx) xb_add(&bar[XB_TOPGEN], 1u);
            else XB_SPIN(xb_ld(&bar[XB_TOPGEN]) == tg, bar);
            __builtin_amdgcn_fence(__ATOMIC_ACQUIRE, "agent");
            xb_add(&bar[XB_XGEN(b.x)], 1u);
            asm volatile("s_waitcnt vmcnt(0)" ::: "memory");
        } else {
            XB_SPIN(xb_ld(&bar[XB_XGEN(b.x)]) == gen, bar);
            __builtin_amdgcn_fence(__ATOMIC_ACQUIRE, "agent");
            asm volatile("s_waitcnt vmcnt(0)" ::: "memory");
        }
    }
    __syncthreads();
}

struct Args {
    const float *x, *mem, *mix_nw, *w_in, *w_gk_up, *b_gk, *gla_nw, *sb_nw, *w_out, *xat_nw, *mem_nw, *w_mq, *w_mkv, *mq_nw, *mk_nw, *w_mo, *ffn_nw, *w_gu, *w_dn;
    float* out; unsigned char* ws;
};

__device__ __forceinline__ void tr_item(const float* W, int ldw, int K, const float* kscale, float cscale, bf16* WT, int k0, int n0src, int drow0, LAS float* scr, int lane, const float* kscale2 = nullptr) {
#pragma unroll
    for (int i = 0; i < 32; ++i) { const int kk = 2 * i + (lane >> 5); const float ks = kscale2 ? ((k0 + kk) < 512 ? kscale[(k0 + kk) & 127] : kscale2[(k0 + kk) & 63]) : (kscale ? kscale[k0 + kk] : 1.0f);
        scr[kk * 33 + (lane & 31)] = W[(size_t)(k0 + kk) * ldw + n0src + (lane & 31)] * (ks * cscale); }
    LDS_FENCE();
    const int c = lane & 7;
#pragma unroll
    for (int j = 0; j < 4; ++j) { const int n = (lane >> 3) + 8 * j; const LAS float* s = scr + (8 * c) * 33 + n;
        u32x4 o; o.x = pk2(s[0 * 33], s[1 * 33]); o.y = pk2(s[2 * 33], s[3 * 33]); o.z = pk2(s[4 * 33], s[5 * 33]); o.w = pk2(s[6 * 33], s[7 * 33]);
        *(u32x4*)(WT + (size_t)(drow0 + n) * K + k0 + 8 * c) = o; }
    LDS_FENCE();
}
__device__ __forceinline__ void row_to_bf16_rs(const float* xrow, bf16* orow, float* rs_out, int lane) {
    const f32x4* xr = (const f32x4*)xrow + lane;
    f32x4 v[4]; float s = 0.f;
#pragma unroll
    for (int j = 0; j < 4; ++j) { v[j] = xr[64 * j]; s += pg8::dot4(v[j]); }
    s = wave_sum(s);
    if (lane == 0) *rs_out = rsqrtf(s * (1.0f / 1024.0f) + EPS);
    u64* o8 = (u64*)orow + lane;
#pragma unroll
    for (int j = 0; j < 4; ++j) o8[64 * j] = (u64)pk2(v[j][0], v[j][1]) | ((u64)pk2(v[j][2], v[j][3]) << 32);
}

__device__ __forceinline__ void p0_do_item(const Args& a, int it, LAS float* scr, int lane) {
    unsigned char* ws = a.ws;
    constexpr int I_INA = 16 * 48, I_INB = 16 * 48, I_SQ = 16 * 32, I_MKV = 16 * 64, I_GU = 16 * 176, I_DN = 44 * 32;
        int r = it;
        if (r < I_INA) { const int kb = r / 48, nb = r % 48, n0 = 32 * nb; tr_item(a.w_in, 3088, 1024, a.mix_nw, n0 < 256 ? 0.125f : 1.0f, (bf16*)(ws + WS_WIN), 64 * kb, n0, n0, scr, lane); return; } r -= I_INA;
        if (r < I_INB) { const int kb = r / 48, nb = r % 48, n0 = 32 * nb; tr_item(a.w_in, 3088, 1024, a.mix_nw, n0 < 512 ? 0.125f * 1.44269504f : 1.0f, (bf16*)(ws + WS_WIN), 64 * kb, 1552 + n0, 1792 + n0, scr, lane); return; } r -= I_INB;
        if (r < I_SQ) { const int kb = r / 32, nb = r % 32; tr_item(a.w_out, 1024, 1024, a.gla_nw, 1.0f, (bf16*)(ws + WS_WOUT), 64 * kb, 32 * nb, 32 * nb, scr, lane, a.sb_nw); return; } r -= I_SQ;
        if (r < I_SQ) { const int kb = r / 32, nb = r % 32; tr_item(a.w_mq, 1024, 1024, a.xat_nw, 1.0f, (bf16*)(ws + WS_WMQ), 64 * kb, 32 * nb, 32 * nb, scr, lane); return; } r -= I_SQ;
        if (r < I_SQ) { const int kb = r / 32, nb = r % 32; tr_item(a.w_mo, 1024, 1024, nullptr, 1.0f, (bf16*)(ws + WS_WMO), 64 * kb, 32 * nb, 32 * nb, scr, lane); return; } r -= I_SQ;
        if (r < I_MKV) { const int kb = r / 64, nb = r % 64; tr_item(a.w_mkv, 2048, 1024, a.mem_nw, 1.0f, (bf16*)(ws + WS_WMKV), 64 * kb, 32 * nb, 32 * nb, scr, lane); return; } r -= I_MKV;
        if (r < I_GU) { const int kb = r / 176, nb = r % 176, n0 = 32 * nb; const int j0 = n0 < DFF ? n0 : n0 - DFF; const int dr = 256 * (j0 / 128) + (j0 % 128) + (n0 < DFF ? 0 : 128);
            tr_item(a.w_gu, 2 * DFF, 1024, a.ffn_nw, 1.0f, (bf16*)(ws + WS_WGU), 64 * kb, n0, dr, scr, lane); return; } r -= I_GU;
        { const int kb = r / 32, nb = r % 32; tr_item(a.w_dn, 1024, DFF, nullptr, 1.0f, (bf16*)(ws + WS_WDN), 64 * kb, 32 * nb, 32 * nb, scr, lane); }
}
__device__ __forceinline__ void p0_prologue(const Args& a, LAS unsigned char* lds, int wid, int lane, int G) {
    unsigned char* ws = a.ws;
    LAS float* scr = (LAS float*)(lds + wid * 16384);
    const int gw = blockIdx.x * 8 + wid, NGW = G * 8;
    constexpr int NITEMS = 16 * 48 * 2 + 3 * 16 * 32 + 16 * 64 + 16 * 176 + 44 * 32;
    {
        int it = gw, m4 = gw * 4;
        while (it < NITEMS || m4 < M) {
            const bool hx = m4 < M;
            f32x4 v[4][4];
            if (hx) {
#pragma unroll
                for (int r = 0; r < 4; ++r) { const f32x4* xr = (const f32x4*)(a.x + (size_t)(m4 + r) * D) + lane;
#pragma unroll
                    for (int jj = 0; jj < 4; ++jj) v[r][jj] = __builtin_nontemporal_load(xr + 64 * jj); }
            }
            if (it < NITEMS) { p0_do_item(a, it, scr, lane); it += NGW; }
            if (hx) {
                float s[4];
#pragma unroll
                for (int r = 0; r < 4; ++r) { float t = 0.f;
#pragma unroll
                    for (int jj = 0; jj < 4; ++jj) t += pg8::dot4(v[r][jj]);
                    s[r] = wave_sum(t); }
#pragma unroll
                for (int r = 0; r < 4; ++r) { if (lane == 0) ((float*)(ws + WS_RS0))[m4 + r] = rsqrtf(s[r] * (1.0f / 1024.0f) + EPS);
                    u64* o8 = (u64*)((bf16*)(ws + WS_R2) + (size_t)(m4 + r) * D) + lane;
#pragma unroll
                    for (int jj = 0; jj < 4; ++jj) o8[64 * jj] = (u64)pk2(v[r][jj][0], v[r][jj][1]) | ((u64)pk2(v[r][jj][2], v[r][jj][3]) << 32); }
                m4 += NGW * 4;
            }
        }
    }
    {
        bf16* WT = (bf16*)(ws + WS_WIN);
        for (int it = blockIdx.x * NTHR + threadIdx.x; it < 256 * 512; it += G * NTHR) {
            const int j = it & 255, k0 = (it >> 8) * 2;
            float up[16];
#pragma unroll
            for (int r = 0; r < 16; ++r) up[r] = a.w_gk_up[r * 256 + j];
            float o[2];
#pragma unroll
            for (int e = 0; e < 2; ++e) { const f32x4* wr_ = (const f32x4*)(a.w_in + (size_t)(k0 + e) * 3088 + 1536); float s = 0.f;
#pragma unroll
                for (int r4 = 0; r4 < 4; ++r4) { const f32x4 wv = wr_[r4]; s += wv[0] * up[4 * r4] + wv[1] * up[4 * r4 + 1] + wv[2] * up[4 * r4 + 2] + wv[3] * up[4 * r4 + 3]; }
                o[e] = s * a.mix_nw[k0 + e]; }
            *(unsigned*)(WT + (size_t)(1536 + j) * 1024 + k0) = pk2(o[0], o[1]);
        }
    }
    for (int m = gw; m < MROWS; m += NGW) row_to_bf16_rs(a.mem + (size_t)m * D, (bf16*)(ws + WS_MEMB) + (size_t)m * D, (float*)(ws + WS_RSM) + m, lane);
}

constexpr int GL_HALF = 73728, GL_BF = 0, GL_KDT = 16640, GL_VT = 25856, GL_QE = 44288, GL_KE = 53504, GL_QB = 62720, GL_TOT = 71936;
struct GlaRaw { float gk[16]; u32x4 q[2]; u32x4 k[2]; u32x4 v[4]; };
template <bool WITHQ, int PART> __device__ __forceinline__ void gla_load_raw(GlaRaw& r, const bf16* PROJ, int unit, int hw, int th) {
    const int c = 2 * unit + hw, bh = c >> 7, n = c & 127, b = bh >> 2, h = bh & 3;
    const size_t row0 = (size_t)b * T + (size_t)n * 64;
    const int d = th & 63, seg = th >> 6, t = th >> 2, dseg = (th & 3) * 16;
    const bf16* gkp = PROJ + row0 * NPROJ + C_GK + h * 64;
    if (PART == 0) {
#pragma unroll
        for (int i = 0; i < 16; ++i) r.gk[i] = bf2f(gkp[(size_t)(16 * seg + i) * NPROJ + d]);
        return;
    }
    const bf16* kp = PROJ + (row0 + t) * NPROJ + C_KG + h * 64 + dseg; r.k[0] = *(const u32x4*)kp; r.k[1] = *(const u32x4*)(kp + 8);
    if (WITHQ) { const bf16* qp = PROJ + (row0 + t) * NPROJ + C_QG + h * 64 + dseg; r.q[0] = *(const u32x4*)qp; r.q[1] = *(const u32x4*)(qp + 8); }
    const bf16* vp = PROJ + (row0 + t) * NPROJ + C_VG + h * 128 + (th & 3) * 32;
#pragma unroll
    for (int i = 0; i < 4; ++i) r.v[i] = *(const u32x4*)(vp + 8 * i);
}
__device__ __forceinline__ void gla_cumsum_r(LAS float* Bf, LAS float* Tot, const GlaRaw& r, int th) {
    const int d = th & 63, seg = th >> 6;
    float acc[16]; float run = 0.f;
#pragma unroll
    for (int i = 0; i < 16; ++i) { run += r.gk[i]; acc[i] = run; }
    Tot[seg * 64 + d] = run;
    __syncthreads();
    float off = 0.f;
#pragma unroll
    for (int s = 0; s < 3; ++s) if (s < seg) off += Tot[s * 64 + d];
#pragma unroll
    for (int i = 0; i < 16; ++i) Bf[(16 * seg + i) * 65 + d] = acc[i] + off;
    __syncthreads();
}
__device__ __forceinline__ void gla_store_vt(LAS bf16* VT, const GlaRaw& r, int t, int dvseg) {
#pragma unroll
    for (int i = 0; i < 4; ++i)
#pragma unroll
        for (int e = 0; e < 4; ++e) { VT[(dvseg + 8 * i + 2 * e) * 72 + t] = (bf16)(r.v[i][e] & 0xffffu); VT[(dvseg + 8 * i + 2 * e + 1) * 72 + t] = (bf16)(r.v[i][e] >> 16); }
}
__device__ __forceinline__ void gla_pass_a_all(const Args& a, LAS unsigned char* lds, int G) {
    const int tid = threadIdx.x, wid = tid >> 6, lane = tid & 63, hw = wid >> 2, wq = wid & 3, th = tid & 255, fr = lane & 15, fq = lane >> 4;
    const bf16* PROJ = (const bf16*)(a.ws + WS_R0); bf16* ST = (bf16*)(a.ws + WS_R3); float* DEC = (float*)(a.ws + WS_DEC);
    LAS unsigned char* L = lds + hw * GL_HALF;
    LAS float* Bf = (LAS float*)(L + GL_BF); LAS float* Tot = (LAS float*)(L + GL_TOT); LAS bf16* KdT = (LAS bf16*)(L + GL_KDT); LAS bf16* VT = (LAS bf16*)(L + GL_VT);
    int unit = blockIdx.x; if (unit >= 1024) return;
    GlaRaw r; gla_load_raw<false, 0>(r, PROJ, unit, hw, th);
    for (; unit < 1024; unit += G) {
        const int c = 2 * unit + hw;
        gla_load_raw<false, 1>(r, PROJ, unit, hw, th);
        gla_cumsum_r(Bf, Tot, r, th);
        {
            const int t = th >> 2, dseg = (th & 3) * 16;
#pragma unroll
            for (int i = 0; i < 16; ++i) { const int d = dseg + i; const unsigned w = (i < 8) ? r.k[0][(i & 7) >> 1] : r.k[1][(i & 7) >> 1]; const float kv = (i & 1) ? bfhi(w) : bflo(w);
                KdT[d * 72 + t] = (bf16)f2bf(kv * __expf(Bf[63 * 65 + d] - Bf[t * 65 + d])); }
            gla_store_vt(VT, r, t, (th & 3) * 32);
            if (th < 64) DEC[(size_t)c * 64 + th] = __expf(Bf[63 * 65 + th]);
        }
        __syncthreads();
        if (unit + G < 1024) gla_load_raw<false, 0>(r, PROJ, unit + G, hw, th);
#pragma unroll
        for (int dvi = 0; dvi < 2; ++dvi) {
            const int dvb = 2 * wq + dvi;
            const bf16x8 a0 = *(const LAS bf16x8*)(VT + (16 * dvb + fr) * 72 + 8 * fq), a1 = *(const LAS bf16x8*)(VT + (16 * dvb + fr) * 72 + 32 + 8 * fq);
#pragma unroll
            for (int dkb = 0; dkb < 4; ++dkb) {
                const bf16x8 b0 = *(const LAS bf16x8*)(KdT + (16 * dkb + fr) * 72 + 8 * fq), b1 = *(const LAS bf16x8*)(KdT + (16 * dkb + fr) * 72 + 32 + 8 * fq);
                f32x4 acc = {0.f, 0.f, 0.f, 0.f};
                acc = MFMA16(a0, b0, acc); acc = MFMA16(a1, b1, acc);
#pragma unroll
                for (int rr = 0; rr < 4; ++rr) ST[(size_t)c * 8192 + (16 * dvb + 4 * fq + rr) * 64 + 16 * dkb + fr] = (bf16)f2bf(acc[rr]);
            }
        }
        __syncthreads();
    }
}
typedef float f32x2s __attribute__((ext_vector_type(2)));
__device__ __forceinline__ void gla_scan_w(const Args& a, int G, int t256) {
    const unsigned* UT = (const unsigned*)(a.ws + WS_R3); const float* DEC = (const float*)(a.ws + WS_DEC); unsigned* STB = (unsigned*)(a.ws + WS_STB);
    for (int base = blockIdx.x * 512; base < 16 * 8192; base += G * 512) {
        const int bh = base >> 13, e0 = (base & 8191) + 2 * t256, dk = e0 & 63;
        float S0 = 0.f, S1 = 0.f;
        for (int n0 = 0; n0 < 128; n0 += 32) {
            unsigned u[32]; f32x2s dc[32];
#pragma unroll
            for (int i = 0; i < 32; ++i) { const size_t c = (size_t)bh * 128 + n0 + i; dc[i] = *(const f32x2s*)(DEC + c * 64 + dk); u[i] = UT[(c * 8192 + e0) >> 1]; }
#pragma unroll
            for (int i = 0; i < 32; ++i) { const size_t c = (size_t)bh * 128 + n0 + i;
                STB[(c * 8192 + e0) >> 1] = pk2(S0, S1); S0 = dc[i][0] * S0 + bflo(u[i]); S1 = dc[i][1] * S1 + bfhi(u[i]); }
        }
    }
}
__device__ __forceinline__ void gla_pass_c_all(const Args& a, LAS unsigned char* lds, int G) {
    const int tid = threadIdx.x, wid = tid >> 6, lane = tid & 63, hw = wid >> 2, ib = wid & 3, th = tid & 255, fr = lane & 15, fq = lane >> 4;
    const bf16* PROJ = (const bf16*)(a.ws + WS_R0); const bf16* STB = (const bf16*)(a.ws + WS_STB); bf16* MIX = (bf16*)(a.ws + WS_R1);
    LAS unsigned char* L = lds + hw * GL_HALF;
    LAS float* Bf = (LAS float*)(L + GL_BF); LAS float* Tot = (LAS float*)(L + GL_TOT); LAS bf16* VT = (LAS bf16*)(L + GL_VT);
    LAS bf16* QE = (LAS bf16*)(L + GL_QE); LAS bf16* KE = (LAS bf16*)(L + GL_KE); LAS bf16* QB = (LAS bf16*)(L + GL_QB);
    int unit = blockIdx.x; if (unit >= 1024) return;
    GlaRaw r; gla_load_raw<true, 0>(r, PROJ, unit, hw, th);
    for (; unit < 1024; unit += G) {
        const int c = 2 * unit + hw, bh = c >> 7, n = c & 127, b = bh >> 2, h = bh & 3;
        const size_t row0 = (size_t)b * T + (size_t)n * 64;
        const size_t tok = row0 + 16 * ib + fr;
        gla_load_raw<true, 1>(r, PROJ, unit, hw, th);
        u32x2 gw[8];
#pragma unroll
        for (int dvb = 0; dvb < 8; ++dvb) gw[dvb] = *(const u32x2*)(PROJ + tok * NPROJ + C_GG + h * 128 + 16 * dvb + 4 * fq);
        gla_cumsum_r(Bf, Tot, r, th);
        {
            const int t = th >> 2, dseg = (th & 3) * 16;
            float qe[16], ke[16], qb[16];
#pragma unroll
            for (int i = 0; i < 16; ++i) { const int d = dseg + i; const unsigned wq_ = (i < 8) ? r.q[0][(i & 7) >> 1] : r.q[1][(i & 7) >> 1], wk_ = (i < 8) ? r.k[0][(i & 7) >> 1] : r.k[1][(i & 7) >> 1];
                const float qv = (i & 1) ? bfhi(wq_) : bflo(wq_), kv = (i & 1) ? bfhi(wk_) : bflo(wk_);
                const float bt = Bf[t * 65 + d], br = Bf[31 * 65 + d]; const float dl = fminf(fmaxf(bt - br, -80.f), 80.f);
                qe[i] = qv * __expf(dl); ke[i] = kv * __expf(-dl); qb[i] = qv * __expf(bt); }
#pragma unroll
            for (int v = 0; v < 2; ++v) {
                u32x4 w;
                w.x = pk2(qe[8 * v + 0], qe[8 * v + 1]); w.y = pk2(qe[8 * v + 2], qe[8 * v + 3]); w.z = pk2(qe[8 * v + 4], qe[8 * v + 5]); w.w = pk2(qe[8 * v + 6], qe[8 * v + 7]); *(LAS u32x4*)(QE + t * 72 + dseg + 8 * v) = w;
                w.x = pk2(ke[8 * v + 0], ke[8 * v + 1]); w.y = pk2(ke[8 * v + 2], ke[8 * v + 3]); w.z = pk2(ke[8 * v + 4], ke[8 * v + 5]); w.w = pk2(ke[8 * v + 6], ke[8 * v + 7]); *(LAS u32x4*)(KE + t * 72 + dseg + 8 * v) = w;
                w.x = pk2(qb[8 * v + 0], qb[8 * v + 1]); w.y = pk2(qb[8 * v + 2], qb[8 * v + 3]); w.z = pk2(qb[8 * v + 4], qb[8 * v + 5]); w.w = pk2(qb[8 * v + 6], qb[8 * v + 7]); *(LAS u32x4*)(QB + t * 72 + dseg + 8 * v) = w;
            }
            gla_store_vt(VT, r, t, (th & 3) * 32);
        }
        bf16x8 sfr[8][2];
#pragma unroll
        for (int dvb = 0; dvb < 8; ++dvb) { const bf16* sp = STB + (size_t)c * 8192 + (16 * dvb + fr) * 64 + 8 * fq; sfr[dvb][0] = *(const bf16x8*)sp; sfr[dvb][1] = *(const bf16x8*)(sp + 32); }
        __syncthreads();
        if (unit + G < 1024) gla_load_raw<true, 0>(r, PROJ, unit + G, hw, th);
        {
            f32x4 accA[4];
            const bf16x8 qe0 = *(const LAS bf16x8*)(QE + (16 * ib + fr) * 72 + 8 * fq), qe1 = *(const LAS bf16x8*)(QE + (16 * ib + fr) * 72 + 32 + 8 * fq);
#pragma unroll
            for (int jb = 0; jb < 4; ++jb) {
                accA[jb] = (f32x4){0.f, 0.f, 0.f, 0.f};
                if (jb <= ib) {
                    const bf16x8 ke0 = *(const LAS bf16x8*)(KE + (16 * jb + fr) * 72 + 8 * fq), ke1 = *(const LAS bf16x8*)(KE + (16 * jb + fr) * 72 + 32 + 8 * fq);
                    accA[jb] = MFMA16(ke0, qe0, accA[jb]); accA[jb] = MFMA16(ke1, qe1, accA[jb]);
                    if (jb == ib) {
#pragma unroll
                        for (int rr = 0; rr < 4; ++rr) if (4 * fq + rr > fr) accA[jb][rr] = 0.f;
                    }
                }
            }
            const bf16x8 P0 = pk8(accA[0], accA[1]), P1 = pk8(accA[2], accA[3]);
            const bf16x8 qb0 = *(const LAS bf16x8*)(QB + (16 * ib + fr) * 72 + 8 * fq), qb1 = *(const LAS bf16x8*)(QB + (16 * ib + fr) * 72 + 32 + 8 * fq);
            f32x4 o[8]; float ssq = 0.f;
#pragma unroll
            for (int dvb = 0; dvb < 8; ++dvb) {
                f32x4 acc = {0.f, 0.f, 0.f, 0.f};
                const LAS bf16* vrow = VT + (16 * dvb + fr) * 72 + 4 * fq;
                { const bf16x8 av = mk8(*(const LAS u32x2*)(vrow), *(const LAS u32x2*)(vrow + 16)); acc = MFMA16(av, P0, acc); }
                if (ib >= 2) { const bf16x8 av = mk8(*(const LAS u32x2*)(vrow + 32), *(const LAS u32x2*)(vrow + 48)); acc = MFMA16(av, P1, acc); }
                acc = MFMA16(sfr[dvb][0], qb0, acc);
                acc = MFMA16(sfr[dvb][1], qb1, acc);
                o[dvb] = acc; ssq += pg8::dot4(acc);
            }
            ssq += __shfl_xor(ssq, 16); ssq += __shfl_xor(ssq, 32);
            const float rs = rsqrtf(ssq * (1.0f / 128.0f) + EPS);
#pragma unroll
            for (int dvb = 0; dvb < 8; ++dvb) {
                const int dv = 16 * dvb + 4 * fq;
                const float g0 = bflo(gw[dvb].x), g1 = bfhi(gw[dvb].x), g2 = bflo(gw[dvb].y), g3 = bfhi(gw[dvb].y);
                u32x2 w; w.x = pk2(o[dvb][0] * rs * pg8::silu_f(g0), o[dvb][1] * rs * pg8::silu_f(g1)); w.y = pk2(o[dvb][2] * rs * pg8::silu_f(g2), o[dvb][3] * rs * pg8::silu_f(g3));
                *(u32x2*)(MIX + tok * 1024 + h * 128 + dv) = w;
            }
        }
        __syncthreads();
    }
}
constexpr float SB_STOP = -57.7f;
__device__ __forceinline__ void sb_pair(const Args& a, int pair, LAS bf16* Vl, int lane) {
    const int fr = lane & 15, fq = lane >> 4;
    const bf16* PROJ = (const bf16*)(a.ws + WS_R0); bf16* MIX = (bf16*)(a.ws + WS_R1);
    const int bh = pair >> 8, jt = pair & 255, b = bh >> 3, h = bh & 7, t0 = 32 * jt;
    const size_t rowb = (size_t)b * T;
    bf16x8 q0[2], q1[2];
#pragma unroll
    for (int u = 0; u < 2; ++u) { const bf16* qp = PROJ + (rowb + t0 + 16 * u + fr) * NPROJ + C_QS + h * 64 + 8 * fq; q0[u] = *(const bf16x8*)qp; q1[u] = *(const bf16x8*)(qp + 32); }
    bf16x8 Tf[2];
#pragma unroll
    for (int bb = 0; bb < 2; ++bb)
#pragma unroll
        for (int jj = 0; jj < 8; ++jj) { const int j = (jj < 4) ? 4 * fq + jj : 16 + 4 * fq + (jj - 4); Tf[bb][jj] = (j > 16 * bb + fr) ? (short)0x3F80 : (short)0; }
    f32x4 o[2][4];
#pragma unroll
    for (int u = 0; u < 2; ++u)
#pragma unroll
        for (int c = 0; c < 4; ++c) o[u][c] = (f32x4){0.f, 0.f, 0.f, 0.f};
    float carry[2] = {0.f, 0.f};
    int kt0 = t0;
    const int vs = lane >> 1, vhalf = lane & 1;
    const bf16* vbase = PROJ + rowb * NPROJ + C_VS + h * 64 + 32 * vhalf;
    const bf16* kbase = PROJ + rowb * NPROJ + C_KS + h * 64 + 8 * fq;
    u32x4 vcur[4]; bf16x8 kcur[2][2];
#pragma unroll
    for (int i = 0; i < 4; ++i) vcur[i] = *(const u32x4*)(vbase + (size_t)(kt0 + vs) * NPROJ + 8 * i);
#pragma unroll
    for (int bb = 0; bb < 2; ++bb) { const bf16* kp = kbase + (size_t)(kt0 + 16 * bb + fr) * NPROJ; kcur[bb][0] = *(const bf16x8*)kp; kcur[bb][1] = *(const bf16x8*)(kp + 32); }
    for (;;) {
#pragma unroll
        for (int i = 0; i < 4; ++i)
#pragma unroll
            for (int e = 0; e < 4; ++e) { Vl[(32 * vhalf + 8 * i + 2 * e) * 36 + vs] = (bf16)(vcur[i][e] & 0xffffu); Vl[(32 * vhalf + 8 * i + 2 * e + 1) * 36 + vs] = (bf16)(vcur[i][e] >> 16); }
        f32x4 S[2][2];
#pragma unroll
        for (int u = 0; u < 2; ++u)
#pragma unroll
            for (int bb = 0; bb < 2; ++bb) { S[u][bb] = (f32x4){0.f, 0.f, 0.f, 0.f}; S[u][bb] = MFMA16(kcur[bb][0], q0[u], S[u][bb]); S[u][bb] = MFMA16(kcur[bb][1], q1[u], S[u][bb]); }
        { const int kn = kt0 >= 32 ? kt0 - 32 : 0;
#pragma unroll
          for (int i = 0; i < 4; ++i) vcur[i] = *(const u32x4*)(vbase + (size_t)(kn + vs) * NPROJ + 8 * i);
#pragma unroll
          for (int bb = 0; bb < 2; ++bb) { const bf16* kp = kbase + (size_t)(kn + 16 * bb + fr) * NPROJ; kcur[bb][0] = *(const bf16x8*)kp; kcur[bb][1] = *(const bf16x8*)(kp + 32); } }
        bf16x8 P[2]; float tot[2];
#pragma unroll
        for (int u = 0; u < 2; ++u) {
            const int t = t0 + 16 * u + fr;
            f32x4 Lm[2], lb[2]; float tt = 0.f;
#pragma unroll
            for (int bb = 0; bb < 2; ++bb)
#pragma unroll
                for (int r = 0; r < 4; ++r) { const bool ok = (kt0 + 16 * bb + 4 * fq + r) < t; const float z = S[u][bb][r];
                    const float sp = fmaxf(z, 0.f) + __builtin_amdgcn_logf(1.0f + __builtin_amdgcn_exp2f(-fabsf(z)));
                    Lm[bb][r] = ok ? -sp : 0.f; lb[bb][r] = ok ? (z - sp) : -1.0e30f; tt += Lm[bb][r]; }
            const bf16x8 Lhi = pk8(Lm[0], Lm[1]);
            f32x4 d0, d1;
            { const u32x4 w = __builtin_bit_cast(u32x4, Lhi);
              d0[0] = Lm[0][0] - bflo(w.x); d0[1] = Lm[0][1] - bfhi(w.x); d0[2] = Lm[0][2] - bflo(w.y); d0[3] = Lm[0][3] - bfhi(w.y);
              d1[0] = Lm[1][0] - bflo(w.z); d1[1] = Lm[1][1] - bfhi(w.z); d1[2] = Lm[1][2] - bflo(w.w); d1[3] = Lm[1][3] - bfhi(w.w); }
            const bf16x8 Llo = pk8(d0, d1);
            f32x4 R[2];
#pragma unroll
            for (int bb = 0; bb < 2; ++bb) { R[bb] = (f32x4){0.f, 0.f, 0.f, 0.f}; R[bb] = MFMA16(Tf[bb], Lhi, R[bb]); R[bb] = MFMA16(Tf[bb], Llo, R[bb]); }
            tt += __shfl_xor(tt, 16); tt += __shfl_xor(tt, 32);
            f32x4 pp[2];
#pragma unroll
            for (int bb = 0; bb < 2; ++bb)
#pragma unroll
                for (int r = 0; r < 4; ++r) pp[bb][r] = __builtin_amdgcn_exp2f(lb[bb][r] + R[bb][r] + carry[u]);
            P[u] = pk8(pp[0], pp[1]); tot[u] = tt;
        }
        LDS_FENCE();
#pragma unroll
        for (int c = 0; c < 4; ++c) { const LAS bf16* vrow = Vl + (16 * c + fr) * 36 + 4 * fq;
            const bf16x8 av = mk8(*(const LAS u32x2*)(vrow), *(const LAS u32x2*)(vrow + 16)); o[0][c] = MFMA16(av, P[0], o[0][c]); o[1][c] = MFMA16(av, P[1], o[1][c]); }
        LDS_FENCE();
        carry[0] += tot[0]; carry[1] += tot[1];
        if (kt0 == 0 || __all(fmaxf(carry[0], carry[1]) < SB_STOP)) break;
        kt0 -= 32;
    }
#pragma unroll
    for (int u = 0; u < 2; ++u) {
        float ssq = 0.f;
#pragma unroll
        for (int c = 0; c < 4; ++c) ssq += pg8::dot4(o[u][c]);
        ssq += __shfl_xor(ssq, 16); ssq += __shfl_xor(ssq, 32);
        const float rs = rsqrtf(ssq * (1.0f / 64.0f) + EPS);
#pragma unroll
        for (int c = 0; c < 4; ++c) { const int dv = 16 * c + 4 * fq;
            u32x2 w; w.x = pk2(o[u][c][0] * rs, o[u][c][1] * rs); w.y = pk2(o[u][c][2] * rs, o[u][c][3] * rs);
            *(u32x2*)(MIX + (rowb + t0 + 16 * u + fr) * 1024 + 512 + h * 64 + dv) = w; }
    }
}

constexpr int XPK = 272, XPV = 260;
__device__ __forceinline__ void xattn_unit(const Args& a, LAS unsigned char* lds, int unit) {
    const int tid = threadIdx.x, wid = tid >> 6, lane = tid & 63, fr = lane & 15, fq = lane >> 4;
    const bf16* KV = (const bf16*)(a.ws + WS_KV); const float* SSQK = (const float*)(a.ws + WS_SSQK); const float* SSQQ = (const float*)(a.ws + WS_SSQQ);
    const bf16* Q = (const bf16*)(a.ws + WS_R1); bf16* XO = (bf16*)(a.ws + WS_R3);
    const int tile = unit >> 2, h = unit & 3, b = tile >> 5;
    const size_t row0 = (size_t)tile * 256;
    LAS bf16* IM = (LAS bf16*)lds;
    {
        const int m = tid >> 1, half = tid & 1; const size_t kr = (size_t)(b * MEML + m);
        const f32x4 pq = *(const f32x4*)(SSQK + kr * 16 + h * 4);
        const float rk = rsqrtf(pg8::hsum4(pq) * (1.0f / 256.0f) + EPS) * 0.0625f;
        const bf16* kp = KV + kr * 2048 + h * 256 + 128 * half;
#pragma unroll
        for (int i = 0; i < 16; ++i) { const int d = 128 * half + 8 * i; const u32x4 w = *(const u32x4*)(kp + 8 * i);
            u32x4 o; o.x = pk2(bflo(w.x) * rk, bfhi(w.x) * rk); o.y = pk2(bflo(w.y) * rk, bfhi(w.y) * rk);
            o.z = pk2(bflo(w.z) * rk, bfhi(w.z) * rk); o.w = pk2(bflo(w.w) * rk, bfhi(w.w) * rk);
            *(LAS u32x4*)(IM + m * XPK + d) = o; }
    }
    __syncthreads();
    bf16x8 Pf[2][8];
#pragma unroll
    for (int qb = 0; qb < 2; ++qb) {
        const size_t tok = row0 + 32 * wid + 16 * qb + fr;
        bf16x8 Qf[8];
#pragma unroll
        for (int ks = 0; ks < 8; ++ks) Qf[ks] = *(const bf16x8*)(Q + tok * 1024 + h * 256 + 32 * ks + 8 * fq);
        const f32x4 pq = *(const f32x4*)(SSQQ + tok * 16 + h * 4);
        const float rq = rsqrtf(pg8::hsum4(pq) * (1.0f / 256.0f) + EPS);
        f32x4 S[16]; float mx = -3.0e38f;
#pragma unroll
        for (int mb = 0; mb < 16; ++mb) { f32x4 acc = {0.f, 0.f, 0.f, 0.f};
#pragma unroll
            for (int ks = 0; ks < 8; ++ks) { const bf16x8 kf = *(const LAS bf16x8*)(IM + (16 * mb + fr) * XPK + 32 * ks + 8 * fq); acc = MFMA16(kf, Qf[ks], acc); }
            acc = acc * rq; S[mb] = acc; mx = fmaxf(mx, fmaxf(fmaxf(acc[0], acc[1]), fmaxf(acc[2], acc[3]))); }
        mx = fmaxf(mx, __shfl_xor(mx, 16)); mx = fmaxf(mx, __shfl_xor(mx, 32));
        float sum = 0.f;
#pragma unroll
        for (int mb = 0; mb < 16; ++mb) {
#pragma unroll
            for (int r = 0; r < 4; ++r) { const float e = __expf(S[mb][r] - mx); S[mb][r] = e; sum += e; } }
        sum += __shfl_xor(sum, 16); sum += __shfl_xor(sum, 32);
        const float inv = 1.0f / sum;
#pragma unroll
        for (int kp = 0; kp < 8; ++kp) Pf[qb][kp] = pk8(S[2 * kp] * inv, S[2 * kp + 1] * inv);
        __builtin_amdgcn_sched_barrier(0);
    }
    __syncthreads();
    {
        const int m = tid >> 1, half = tid & 1; const bf16* vp = KV + (size_t)(b * MEML + m) * 2048 + 1024 + h * 256 + 128 * half;
#pragma unroll
        for (int i = 0; i < 16; ++i) { const u32x4 w = *(const u32x4*)(vp + 8 * i); const int dv = 128 * half + 8 * i;
#pragma unroll
            for (int e = 0; e < 4; ++e) { IM[(dv + 2 * e) * XPV + m] = (bf16)(w[e] & 0xffffu); IM[(dv + 2 * e + 1) * XPV + m] = (bf16)(w[e] >> 16); } }
    }
    __syncthreads();
    {
        const size_t tok0 = row0 + 32 * wid + fr, tok1 = tok0 + 16;
#pragma unroll
        for (int dvb = 0; dvb < 16; ++dvb) { f32x4 acc0 = {0.f, 0.f, 0.f, 0.f}, acc1 = {0.f, 0.f, 0.f, 0.f};
            const LAS bf16* vrow = IM + (16 * dvb + fr) * XPV + 4 * fq;
#pragma unroll
            for (int kp = 0; kp < 8; ++kp) { const bf16x8 av = mk8(*(const LAS u32x2*)(vrow + 32 * kp), *(const LAS u32x2*)(vrow + 32 * kp + 16)); acc0 = MFMA16(av, Pf[0][kp], acc0); acc1 = MFMA16(av, Pf[1][kp], acc1); }
            u32x2 w; w.x = pk2(acc0[0], acc0[1]); w.y = pk2(acc0[2], acc0[3]);
            *(u32x2*)(XO + tok0 * 1024 + h * 256 + 16 * dvb + 4 * fq) = w;
            w.x = pk2(acc1[0], acc1[1]); w.y = pk2(acc1[2], acc1[3]);
            *(u32x2*)(XO + tok1 * 1024 + h * 256 + 16 * dvb + 4 * fq) = w; __builtin_amdgcn_sched_barrier(0); }
    }
    __syncthreads();
}

__global__ void __launch_bounds__(NTHR, 2) hybrid_fwd(Args a) {
    extern __shared__ __attribute__((aligned(16))) unsigned char lds_raw[];
    LAS unsigned char* lds = (LAS unsigned char*)lds_raw;
    cg::grid_group grid = cg::this_grid();
    volatile LAS unsigned* bst = (volatile LAS unsigned*)(lds + 146688);
    if (threadIdx.x < 2) bst[threadIdx.x] = 0u;
    __syncthreads();
    XcdBarrier bar = xcd_barrier_post((unsigned*)(a.ws + WS_CTL), bst);
#define GRID_SYNC() do { xcd_barrier(bar); } while (0)
    if (a.ws == nullptr) grid.sync();
    const int tid = threadIdx.x, wid = __builtin_amdgcn_readfirstlane(tid >> 6), lane = tid & 63, G = gridDim.x;
    unsigned char* ws = a.ws;
    bf16* PROJ = (bf16*)(ws + WS_R0); bf16* R1 = (bf16*)(ws + WS_R1); bf16* R2 = (bf16*)(ws + WS_R2);

    p0_prologue(a, lds, wid, lane, G);
    GRID_SYNC();
    {
        pg8::Gemm g{R2, (const bf16*)(ws + WS_WIN), M, NPROJ, D}; pg8::StaticOrder S; S.init(M, NPROJ, G, (int)blockIdx.x);
        pg8::EpiScale<0> E{PROJ, NPROJ, (const float*)(ws + WS_RS0), a.b_gk, nullptr, nullptr};
        pg8::gemm_phase<pg8::EpiScale<0>, pg8::StaticOrder, true, true>(lds, g, S, E);
    }
    {
        pg8::Gemm g{(const bf16*)(ws + WS_MEMB), (const bf16*)(ws + WS_WMKV), MROWS, 2048, D}; pg8::StaticOrder S; S.init(MROWS, 2048, G, (int)((blockIdx.x + G / 2) % G));
        pg8::EpiScale<1> E{(bf16*)(ws + WS_KV), 2048, (const float*)(ws + WS_RSM), nullptr, (float*)(ws + WS_SSQK), nullptr};
        pg8::gemm_phase<pg8::EpiScale<1>, pg8::StaticOrder, true, true>(lds, g, S, E);
    }
    GRID_SYNC();
    gla_pass_a_all(a, lds, G);
    GRID_SYNC();
    {
        LAS unsigned* qctr = (LAS unsigned*)(lds + 146696);
        if (tid == 0) *qctr = 0u;
        __syncthreads();
        if (wid < 4) gla_scan_w(a, G, tid);
        for (;;) {
            unsigned idx = 0;
            if (lane == 0) idx = __hip_atomic_fetch_add(qctr, 1u, __ATOMIC_RELAXED, __HIP_MEMORY_SCOPE_WORKGROUP);
            idx = (unsigned)__builtin_amdgcn_readfirstlane((int)idx);
            const unsigned pr = (G == 256) ? (unsigned)blockIdx.x * 32u + idx : (unsigned)blockIdx.x + idx * (unsigned)G;
            if ((G == 256 && idx >= 32u) || pr >= 8192u) break;
            sb_pair(a, (int)pr, (LAS bf16*)(lds + wid * 8192), lane);
        }
    }
    GRID_SYNC();
    gla_pass_c_all(a, lds, G);
    GRID_SYNC();
    {
        pg8::Gemm g{R1, (const bf16*)(ws + WS_WOUT), M, D, D}; pg8::StaticOrder S; S.init(M, D, G, (int)blockIdx.x);
        pg8::EpiRes<0> E{a.x, nullptr, nullptr, R2, (float*)(ws + WS_SSQ1)};
        pg8::gemm_phase<pg8::EpiRes<0>, pg8::StaticOrder, true, true>(lds, g, S, E);
    }
    GRID_SYNC();
    {
        pg8::Gemm g{R2, (const bf16*)(ws + WS_WMQ), M, D, D}; pg8::StaticOrder S; S.init(M, D, G, (int)blockIdx.x);
        pg8::EpiScale<2> E{R1, D, (const float*)(ws + WS_SSQ1), a.mq_nw, (float*)(ws + WS_SSQQ), a.mk_nw};
        pg8::gemm_phase<pg8::EpiScale<2>, pg8::StaticOrder, true, true>(lds, g, S, E);
    }
    GRID_SYNC();
    for (int u = blockIdx.x; u < 512; u += G) xattn_unit(a, lds, u);
    GRID_SYNC();
    {
        pg8::Gemm g{(const bf16*)(ws + WS_R3), (const bf16*)(ws + WS_WMO), M, D, D}; pg8::StaticOrder S; S.init(M, D, G, (int)blockIdx.x);
        pg8::EpiRes<1> E{nullptr, R2, nullptr, R1, (float*)(ws + WS_SSQ2)};
        pg8::gemm_phase<pg8::EpiRes<1>, pg8::StaticOrder, true, true>(lds, g, S, E);
    }
    GRID_SYNC();
    {
        pg8::Gemm g{R1, (const bf16*)(ws + WS_WGU), M, 2 * DFF, D}; pg8::StaticOrder S; S.init(M, 2 * DFF, G, (int)blockIdx.x);
        const pg8::RstdTab RT = pg8::fill_rstd_table(S, (const float*)(ws + WS_SSQ2), (LAS float*)(lds + 131072));
        pg8::EpiGateUp E{PROJ, (const float*)(ws + WS_SSQ2), RT};
        pg8::gemm_phase<pg8::EpiGateUp, pg8::StaticOrder, true, true>(lds, g, S, E);
    }
    GRID_SYNC();
    {
        pg8::Gemm g{PROJ, (const bf16*)(ws + WS_WDN), M, D, DFF}; pg8::StaticOrder S; S.init(M, D, G, (int)blockIdx.x);
        pg8::EpiRes<2> E{nullptr, R1, a.out, nullptr, nullptr};
        pg8::gemm_phase<pg8::EpiRes<2>, pg8::StaticOrder, true, true>(lds, g, S, E);
    }
}

extern "C" void kernel_launch(void* const* d_in, const int* in_sizes, int n_in, void* d_out, int out_size, void* d_ws, size_t ws_size, hipStream_t stream) {
    static int grid = 0;
    if (grid == 0) {
        if (n_in != 19 || in_sizes[0] != M * D || out_size != M * D || ws_size < WS_END) { fprintf(stderr, "kernel_launch: unexpected shapes (n_in %d, ws %zu)\n", n_in, ws_size); grid = -1; return; }
        int dev = 0, cus = 0, per_cu = 0;
        if (hipGetDevice(&dev) != hipSuccess || hipDeviceGetAttribute(&cus, hipDeviceAttributeMultiprocessorCount, dev) != hipSuccess) { grid = -1; return; }
        if (hipFuncSetAttribute((const void*)hybrid_fwd, hipFuncAttributeMaxDynamicSharedMemorySize, LDS_BYTES) != hipSuccess) { fprintf(stderr, "kernel_launch: hipFuncSetAttribute failed\n"); grid = -1; return; }
        if (hipOccupancyMaxActiveBlocksPerMultiprocessor(&per_cu, (const void*)hybrid_fwd, NTHR, LDS_BYTES) != hipSuccess || per_cu < 1) { fprintf(stderr, "kernel_launch: occupancy query says %d\n", per_cu); per_cu = 1; }
        (void)hipGetLastError();
        grid = cus;
    }
    if (grid < 0) return;
    if (hipMemsetAsync((char*)d_ws + WS_CTL, 0, 16384, stream) != hipSuccess) { fprintf(stderr, "kernel_launch: memset failed\n"); return; }
    Args a{};
    a.x = (const float*)d_in[0]; a.mem = (const float*)d_in[1]; a.mix_nw = (const float*)d_in[2]; a.w_in = (const float*)d_in[3]; a.w_gk_up = (const float*)d_in[4]; a.b_gk = (const float*)d_in[5];
    a.gla_nw = (const float*)d_in[6]; a.sb_nw = (const float*)d_in[7]; a.w_out = (const float*)d_in[8]; a.xat_nw = (const float*)d_in[9]; a.mem_nw = (const float*)d_in[10]; a.w_mq = (const float*)d_in[11];
    a.w_mkv = (const float*)d_in[12]; a.mq_nw = (const float*)d_in[13]; a.mk_nw = (const float*)d_in[14]; a.w_mo = (const float*)d_in[15]; a.ffn_nw = (const float*)d_in[16]; a.w_gu = (const float*)d_in[17]; a.w_dn = (const float*)d_in[18];
    a.out = (float*)d_out; a.ws = (unsigned char*)d_ws;
    void* args[] = {&a};
    hipError_t e = hipLaunchCooperativeKernel((const void*)hybrid_fwd, dim3(grid), dim3(NTHR), args, LDS_BYTES, stream);
    if (e != hipSuccess) fprintf(stderr, "kernel_launch: cooperative launch failed: %s (grid %d)\n", hipGetErrorString(e), grid);
}
```

```cpp
#include <hip/hip_runtime.h>
#include <hip/hip_cooperative_groups.h>
#include <cstdio>
#include <cstdint>
namespace cg = cooperative_groups;
namespace pg8 {
#define PG8_LAS __attribute__((address_space(3)))
typedef unsigned short bf16_t;
typedef short bf16x8 __attribute__((ext_vector_type(8)));
typedef float f32x4 __attribute__((ext_vector_type(4)));
typedef unsigned u32x4 __attribute__((ext_vector_type(4)));
constexpr int BM = 256, BK = 64, HALF = 128, HTB = HALF * BK * 2  , STAGE_BYTES = 8 * HTB, NXCD = 8, WGM = 8;

__host__ __device__ __forceinline__ int lds_byte(int r, int c) { const int st = (r >> 4) * 2 + (c >> 5), rr = r & 15, cc = c & 31, ob = rr * 64 + cc * 2; return st * 1024 + (ob ^ (((ob >> 9) & 1) << 5)); }
__host__ __device__ __forceinline__ void stage_rc(int b, int& R, int& C) { const int st = b / 1024, sb = b % 1024, swz = sb ^ (((sb >> 9) & 1) << 5); R = (st >> 1) * 16 + swz / 64; C = (st & 1) * 32 + (swz % 64) / 2; }
__host__ __device__ __forceinline__ int perm32(int rho) { const int n = rho >> 4, i = rho & 15; return 8 * (i >> 2) + 4 * n + (i & 3); }

struct Unit { int pm, pn; };
struct Gemm { const bf16_t* A; const bf16_t* Bt; int M, N, K; };

struct StaticOrder {
    int nM, nN, nwg, G, c;
    __host__ __device__ void init(int M, int N, int G_, int c_) { nM = M / BM; nN = N / BM; nwg = nM * nN; G = G_; c = c_; }
    __host__ __device__ bool next(int i, Unit& u) const {
        const long L = (long)i * G + c; if (L >= nwg) return false;
        int wgid = (int)L; { const int q = nwg / NXCD, r = nwg % NXCD, xcd = wgid % NXCD, off = wgid / NXCD; wgid = (xcd < r ? xcd * (q + 1) : r * (q + 1) + (xcd - r) * q) + off; }
        const int nig = WGM * nN, gid = wgid / nig, fm = gid * WGM, gsz = (nM - fm) < WGM ? (nM - fm) : WGM;
        u.pm = fm + ((wgid % nig) % gsz); u.pn = (wgid % nig) / gsz; return true;
    }
    __device__ __forceinline__ void a_ready(const Unit&) const {}
    __device__ __forceinline__ void done(const Unit&) const {}
};

__device__ __forceinline__ unsigned cvt_pk_bf16(float lo, float hi) { unsigned r; asm volatile("v_cvt_pk_bf16_f32 %0, %1, %2" : "=v"(r) : "v"(lo), "v"(hi)); return r; }
typedef float f32x2 __attribute__((ext_vector_type(2)));
typedef unsigned u32x2 __attribute__((ext_vector_type(2)));
__device__ __forceinline__ float hsum4(const f32x4 v) { return (v[0] + v[1]) + (v[2] + v[3]); }
__device__ __forceinline__ float dot4(const f32x4 v) { return (v[0] * v[0] + v[1] * v[1]) + (v[2] * v[2] + v[3] * v[3]); }
__device__ __forceinline__ float row_rstd16(const float* ssq, int row, float inv_n, float eps) {
    const f32x4* p = (const f32x4*)(ssq + (size_t)row * 16);
    const f32x4 a = p[0], b = p[1], c = p[2], d = p[3];
    return rsqrtf(((hsum4(a) + hsum4(b)) + (hsum4(c) + hsum4(d))) * inv_n + eps);
}
__device__ __forceinline__ float logsig_f(float v) { return fminf(v, 0.f) - __logf(1.0f + __expf(-fabsf(v))); }
__device__ __forceinline__ float silu_f(float g) { return g * __builtin_amdgcn_rcpf(1.0f + __expf(-g)); }
__device__ __forceinline__ u32x4 pack8(const f32x4 v0, const f32x4 v1) { u32x4 w; w.x = cvt_pk_bf16(v0[0], v0[1]); w.y = cvt_pk_bf16(v0[2], v0[3]); w.z = cvt_pk_bf16(v1[0], v1[1]); w.w = cvt_pk_bf16(v1[2], v1[3]); return w; }
template <int MODE> struct EpiScale {
    static constexpr bool PERM = true, AFTER_DRAIN = false;
    bf16_t* O; int ldc; const float* rs; const float* bias; float* ssq_out; const float* bias2;
    __device__ __forceinline__ void operator()(const f32x4 (&acc)[2][2][4][2], const Unit& u, int wr, int wc, int fr, int fq) const {
        const int row0 = u.pm * BM + wr * 64 + fr, col0 = u.pn * BM + wc * 32 + 8 * fq;
        const bool gk = (MODE == 0) && (u.pn == 6);
        f32x4 bv[2][2];
#pragma unroll
        for (int bj = 0; bj < 2; ++bj)
#pragma unroll
            for (int n = 0; n < 2; ++n) { if (MODE == 2) { const int cd = wc * 32 + 8 * fq + bj * HALF + 4 * n; bv[bj][n] = *(const f32x4*)(bias + cd) * *(const f32x4*)(bias2 + cd); }
                else bv[bj][n] = gk ? *(const f32x4*)(bias + (col0 - 1536) + bj * HALF + 4 * n) : (f32x4){0.f, 0.f, 0.f, 0.f}; }
        float sc8[2][4];
        if (MODE != 2) {
#pragma unroll
            for (int ai = 0; ai < 2; ++ai)
#pragma unroll
                for (int m = 0; m < 4; ++m) sc8[ai][m] = rs[row0 + ai * HALF + m * 16];
            asm volatile("" ::: "memory");
        }
#pragma unroll
        for (int ai = 0; ai < 2; ++ai)
#pragma unroll
            for (int m = 0; m < 4; ++m) {
                const int row = row0 + ai * HALF + m * 16;
                const float s = (MODE == 2) ? row_rstd16(rs, row, 1.0f / 1024.0f, 1e-6f) : sc8[ai][m];
                float q = 0.f;
#pragma unroll
                for (int bj = 0; bj < 2; ++bj) {
                    f32x4 v0 = acc[ai][bj][m][0] * s, v1 = acc[ai][bj][m][1] * s;
                    if (MODE == 0) { if (gk) {
#pragma unroll
                        for (int e = 0; e < 4; ++e) { v0[e] = logsig_f(v0[e] + bv[bj][0][e]) * 0.0625f; v1[e] = logsig_f(v1[e] + bv[bj][1][e]) * 0.0625f; } } }
                    if (MODE != 0) q += dot4(v0) + dot4(v1);
                    if (MODE == 2) { v0 = v0 * bv[bj][0]; v1 = v1 * bv[bj][1]; }
                    *(u32x4*)(O + (size_t)row * ldc + col0 + bj * HALF) = pack8(v0, v1);
                }
                if (MODE != 0) { q += __shfl_xor(q, 16); q += __shfl_xor(q, 32); if (fq == 0 && (MODE == 2 || u.pn < 4)) ssq_out[(size_t)row * 16 + u.pn * 4 + wc] = q; }
            }
    }
};
#ifndef RES_ROWS_BF16
#define RES_ROWS_BF16 4
#endif
template <int RES> struct EpiRes {
    static constexpr bool PERM = true, AFTER_DRAIN = false;
    static constexpr int RB = (RES == 0) ? 2 : RES_ROWS_BF16;
    const float* resid_f; const bf16_t* resid_b; float* out_f; bf16_t* out_b; float* ssq_out;
    __device__ __forceinline__ void operator()(const f32x4 (&acc)[2][2][4][2], const Unit& u, int wr, int wc, int fr, int fq) const {
        const int row0 = u.pm * BM + wr * 64 + fr, col0 = u.pn * BM + wc * 32 + 8 * fq;
#pragma unroll
        for (int g2 = 0; g2 < 8 / RB; ++g2) {
            f32x4 rf[RES == 0 ? RB : 1][2][2]; u32x4 rb[RES == 0 ? 1 : RB][2];
#pragma unroll
            for (int mm = 0; mm < RB; ++mm)
#pragma unroll
                for (int bj = 0; bj < 2; ++bj) { const int rr = g2 * RB + mm; const size_t off = (size_t)(row0 + (rr >> 2) * HALF + (rr & 3) * 16) * 1024 + col0 + bj * HALF;
                    if (RES == 0) { rf[mm][bj][0] = __builtin_nontemporal_load((const f32x4*)(resid_f + off)); rf[mm][bj][1] = __builtin_nontemporal_load((const f32x4*)(resid_f + off + 4)); }
                    else if (RES == 2) rb[mm][bj] = __builtin_nontemporal_load((const u32x4*)(resid_b + off));
                    else rb[mm][bj] = *(const u32x4*)(resid_b + off); }
            asm volatile("" ::: "memory");
#pragma unroll
            for (int mm = 0; mm < RB; ++mm) {
                const int rr = g2 * RB + mm, ai = rr >> 2, m = rr & 3;
                const int row = row0 + ai * HALF + m * 16; float q = 0.f;
#pragma unroll
                for (int bj = 0; bj < 2; ++bj) {
                    const size_t off = (size_t)row * 1024 + col0 + bj * HALF;
                    f32x4 r0, r1;
                    if (RES == 0) { r0 = rf[mm][bj][0]; r1 = rf[mm][bj][1]; }
                    else { const u32x4 w = rb[mm][bj];
                        r0[0] = __builtin_bit_cast(float, w.x << 16); r0[1] = __builtin_bit_cast(float, w.x & 0xffff0000u); r0[2] = __builtin_bit_cast(float, w.y << 16); r0[3] = __builtin_bit_cast(float, w.y & 0xffff0000u);
                        r1[0] = __builtin_bit_cast(float, w.z << 16); r1[1] = __builtin_bit_cast(float, w.z & 0xffff0000u); r1[2] = __builtin_bit_cast(float, w.w << 16); r1[3] = __builtin_bit_cast(float, w.w & 0xffff0000u); }
                    const f32x4 v0 = acc[ai][bj][m][0] + r0, v1 = acc[ai][bj][m][1] + r1;
                    if (RES == 2) { __builtin_nontemporal_store(v0, (f32x4*)(out_f + off)); __builtin_nontemporal_store(v1, (f32x4*)(out_f + off + 4)); }
                    else { q += dot4(v0) + dot4(v1); *(u32x4*)(out_b + off) = pack8(v0, v1); }
                }
                if (RES != 2) { q += __shfl_xor(q, 16); q += __shfl_xor(q, 32); if (fq == 0) ssq_out[(size_t)row * 16 + u.pn * 4 + wc] = q; }
            }
        }
    }
};
struct RstdTab { const PG8_LAS float* tab; int p0, p1, p2, p3; };
template <class Sched> __device__ __forceinline__ RstdTab fill_rstd_table(const Sched& S, const float* ssq, PG8_LAS float* tab) {
    RstdTab T; T.tab = tab; T.p0 = T.p1 = T.p2 = T.p3 = -1;
    Unit u;
    for (int i = 0; S.next(i, u); ++i) { const int pm = u.pm; if (pm == T.p0 || pm == T.p1 || pm == T.p2 || pm == T.p3) continue;
        if (T.p0 < 0) T.p0 = pm; else if (T.p1 < 0) T.p1 = pm; else if (T.p2 < 0) T.p2 = pm; else if (T.p3 < 0) T.p3 = pm; }
    const int tid = threadIdx.x;
#pragma unroll
    for (int s2 = 0; s2 < 4; s2 += 2) { const int s = s2 + (tid >> 8); const int pm = (s == 0) ? T.p0 : (s == 1) ? T.p1 : (s == 2) ? T.p2 : T.p3;
        if (pm >= 0) tab[s * 256 + (tid & 255)] = row_rstd16(ssq, pm * BM + (tid & 255), 1.0f / 1024.0f, 1e-6f); }
    __syncthreads();
    return T;
}
__device__ __forceinline__ int rstd_slot(const RstdTab& T, int pm) { return (pm == T.p0) ? 0 : (pm == T.p1) ? 1 : (pm == T.p2) ? 2 : (pm == T.p3) ? 3 : -1; }
struct EpiGateUp {
    static constexpr bool PERM = true, AFTER_DRAIN = false;
    bf16_t* H; const float* ssq; RstdTab T;
    __device__ __forceinline__ void operator()(const f32x4 (&acc)[2][2][4][2], const Unit& u, int wr, int wc, int fr, int fq) const {
        const int row0 = u.pm * BM + wr * 64 + fr, col0 = u.pn * HALF + wc * 32 + 8 * fq;
        const int slot = rstd_slot(T, u.pm);
        float sc[2][4];
#pragma unroll
        for (int ai = 0; ai < 2; ++ai)
#pragma unroll
            for (int m = 0; m < 4; ++m) { const int rl = wr * 64 + fr + ai * HALF + m * 16;
                sc[ai][m] = (slot >= 0) ? T.tab[slot * 256 + rl] : row_rstd16(ssq, u.pm * BM + rl, 1.0f / 1024.0f, 1e-6f); }
#pragma unroll
        for (int ai = 0; ai < 2; ++ai)
#pragma unroll
            for (int m = 0; m < 4; ++m) {
                const int row = row0 + ai * HALF + m * 16;
                const float s = sc[ai][m];
                f32x4 h0, h1;
#pragma unroll
                for (int e = 0; e < 4; ++e) { h0[e] = silu_f(acc[ai][0][m][0][e] * s) * (acc[ai][1][m][0][e] * s); h1[e] = silu_f(acc[ai][0][m][1][e] * s) * (acc[ai][1][m][1][e] * s); }
                *(u32x4*)(H + (size_t)row * 2816 + col0) = pack8(h0, h1);
            }
    }
};
template <class Epi, class Sched, bool ALIGN_EPI = false, bool SP2 = false>
__device__ __forceinline__ void gemm_phase(PG8_LAS unsigned char* lds, const Gemm g, const Sched& S, const Epi& E) {
    const int tid = threadIdx.x, wid = __builtin_amdgcn_readfirstlane(tid >> 6), lane = tid & 63, wr = wid >> 2, wc = wid & 3, fr = lane & 15, fq = lane >> 4;
    const int K = g.K, nt = K / BK;
    unsigned voffA[2], voffB[2];
#pragma unroll
    for (int i = 0; i < 2; ++i) { int R, C; stage_rc(tid * 16 + i * 8192, R, C); const int Rb = Epi::PERM ? ((R & ~31) + perm32(R & 31)) : R;
        voffA[i] = (unsigned)(R * K + C) * 2u; voffB[i] = (unsigned)(Rb * K + C) * 2u; }
    const size_t kstep = (size_t)(BK * 2);
    const size_t hstep = (size_t)HALF * K * 2;
    const size_t tstep = 2 * hstep;
    const unsigned ldsw = (unsigned)wid * 1024u;
    const int aoff = lds_byte(wr * 64 + fr, fq * 8), boff = lds_byte(wc * 32 + fr, fq * 8);
#define PG8_SA(b, h) (((b) * 2 + (h)) * HTB)
#define PG8_SB(b, h) ((4 + (b) * 2 + (h)) * HTB)
#define PG8_STAGE(bufoff, gbase, voff) do { _Pragma("unroll") for (int _i = 0; _i < 2; ++_i) \
        __builtin_amdgcn_global_load_lds((const unsigned*)((const char*)(gbase) + (voff)[_i]), (PG8_LAS unsigned*)(lds + (bufoff) + ldsw + _i * 8192), 16, 0, 0); } while (0)
#define PG8_LDA(dst, b, h) do { _Pragma("unroll") for (int m = 0; m < 4; ++m) _Pragma("unroll") for (int k = 0; k < 2; ++k) dst[m][k] = *(const PG8_LAS bf16x8*)(lds + PG8_SA(b, h) + aoff + m * 2048 + k * 1024); } while (0)
#define PG8_LDB(dst, b, h) do { _Pragma("unroll") for (int n = 0; n < 2; ++n) _Pragma("unroll") for (int k = 0; k < 2; ++k) dst[n][k] = *(const PG8_LAS bf16x8*)(lds + PG8_SB(b, h) + boff + n * 2048 + k * 1024); } while (0)
#define PG8_MMA(ai, bj, At, Bt) do { __builtin_amdgcn_s_setprio(1); _Pragma("unroll") for (int m = 0; m < 4; ++m) _Pragma("unroll") for (int n = 0; n < 2; ++n) _Pragma("unroll") for (int k = 0; k < 2; ++k) \
        acc[ai][bj][m][n] = __builtin_amdgcn_mfma_f32_16x16x32_bf16(Bt[n][k], At[m][k], acc[ai][bj][m][n], 0, 0, 0); __builtin_amdgcn_s_setprio(0); } while (0)
#define PG8_WAIT_V(n) asm volatile("s_waitcnt vmcnt(" #n ")" ::: "memory")
#define PG8_WAIT_L(n) asm volatile("s_waitcnt lgkmcnt(" #n ")" ::: "memory")
#define PG8_BAR __builtin_amdgcn_s_barrier()
#define PG8_SCHED __builtin_amdgcn_sched_barrier(0)
    Unit cur, nxt; int ui = 0;
    if (!S.next(0, cur)) return;
    f32x4 acc[2][2][4][2];
#pragma unroll
    for (int a = 0; a < 2; ++a)
#pragma unroll
        for (int b = 0; b < 2; ++b)
#pragma unroll
            for (int m = 0; m < 4; ++m)
#pragma unroll
                for (int n = 0; n < 2; ++n) acc[a][b][m][n] = (f32x4){0.f, 0.f, 0.f, 0.f};
    bf16x8 At[4][2], B0[2][2], B1[2][2];
    const char* cA = (const char*)g.A + (size_t)cur.pm * tstep; const char* cB = (const char*)g.Bt + (size_t)cur.pn * tstep;
    S.a_ready(cur);
    if constexpr (SP2) {
        PG8_STAGE(PG8_SB(0, 0), cB, voffB); PG8_STAGE(PG8_SB(0, 1), cB + hstep, voffB); PG8_STAGE(PG8_SA(0, 0), cA, voffA); PG8_STAGE(PG8_SA(0, 1), cA + hstep, voffA);
        if (wr == 1) PG8_BAR;
        PG8_WAIT_V(2); PG8_BAR;
        PG8_STAGE(PG8_SB(1, 0), cB + kstep, voffB); PG8_STAGE(PG8_SA(1, 0), cA + kstep, voffA); PG8_STAGE(PG8_SB(1, 1), cB + hstep + kstep, voffB);
        PG8_WAIT_V(6); PG8_BAR;
    } else {
        PG8_STAGE(PG8_SB(0, 0), cB, voffB); PG8_STAGE(PG8_SA(0, 0), cA, voffA); PG8_STAGE(PG8_SB(0, 1), cB + hstep, voffB); PG8_STAGE(PG8_SA(0, 1), cA + hstep, voffA);
        if (wr == 1) PG8_BAR;
        PG8_WAIT_V(4); PG8_BAR;
        PG8_STAGE(PG8_SB(1, 0), cB + kstep, voffB); PG8_STAGE(PG8_SA(1, 0), cA + kstep, voffA); PG8_STAGE(PG8_SB(1, 1), cB + hstep + kstep, voffB);
        PG8_WAIT_V(6); PG8_BAR;
    }
    for (;;) {
        const bool has_next = S.next(ui + 1, nxt);
        const char* nA = has_next ? (const char*)g.A + (size_t)nxt.pm * tstep : cA; const char* nB = has_next ? (const char*)g.Bt + (size_t)nxt.pn * tstep : cB;
        for (int t = 0; t < nt; t += 2) {
            const bool last = (t == nt - 2);
            const char* a1 = cA + (size_t)(t + 1) * kstep;
            const char* a2 = last ? nA : cA + (size_t)(t + 2) * kstep; const char* b2 = last ? nB : cB + (size_t)(t + 2) * kstep;
            const char* a3 = a2 + kstep; const char* b3 = b2 + kstep;
            if (last && has_next) S.a_ready(nxt);
            if constexpr (SP2) {
            PG8_LDB(B0, 0, 0); PG8_LDB(B1, 0, 1); PG8_SCHED; PG8_LDA(At, 0, 0); PG8_STAGE(PG8_SA(1, 1), a1 + hstep, voffA);
            PG8_WAIT_V(8); PG8_WAIT_L(0); PG8_BAR; PG8_MMA(0, 0, At, B0); PG8_MMA(0, 1, At, B1); PG8_BAR; PG8_SCHED;
            PG8_LDA(At, 0, 1); PG8_STAGE(PG8_SB(0, 0), b2, voffB); PG8_STAGE(PG8_SB(0, 1), b2 + hstep, voffB); PG8_STAGE(PG8_SA(0, 0), a2, voffA);
            PG8_WAIT_V(8); PG8_WAIT_L(0); PG8_BAR; PG8_MMA(1, 0, At, B0); PG8_MMA(1, 1, At, B1); PG8_BAR; PG8_SCHED;
            PG8_LDB(B0, 1, 0); PG8_LDB(B1, 1, 1); PG8_SCHED; PG8_LDA(At, 1, 0); PG8_STAGE(PG8_SA(0, 1), a2 + hstep, voffA);
            PG8_WAIT_V(8); PG8_WAIT_L(0); PG8_BAR; PG8_MMA(0, 0, At, B0); PG8_MMA(0, 1, At, B1); PG8_BAR; PG8_SCHED;
            PG8_LDA(At, 1, 1); PG8_STAGE(PG8_SB(1, 0), b3, voffB); PG8_STAGE(PG8_SB(1, 1), b3 + hstep, voffB); PG8_STAGE(PG8_SA(1, 0), a3, voffA);
            PG8_WAIT_V(8); PG8_WAIT_L(0); PG8_BAR; PG8_MMA(1, 0, At, B0); PG8_MMA(1, 1, At, B1); PG8_BAR; PG8_SCHED;
            } else {
            PG8_LDB(B0, 0, 0); PG8_SCHED; PG8_LDA(At, 0, 0); PG8_STAGE(PG8_SA(1, 1), a1 + hstep, voffA);
            PG8_WAIT_L(8); PG8_BAR; PG8_WAIT_L(0); PG8_MMA(0, 0, At, B0); PG8_BAR; PG8_SCHED;
            PG8_LDB(B1, 0, 1); PG8_STAGE(PG8_SB(0, 0), b2, voffB);
            PG8_BAR; PG8_WAIT_L(0); PG8_MMA(0, 1, At, B1); PG8_BAR;
            PG8_LDA(At, 0, 1); PG8_STAGE(PG8_SA(0, 0), a2, voffA);
            PG8_BAR; PG8_WAIT_L(0); PG8_MMA(1, 0, At, B0); PG8_BAR; PG8_SCHED;
            PG8_STAGE(PG8_SB(0, 1), b2 + hstep, voffB);
            PG8_WAIT_V(6); PG8_BAR; PG8_MMA(1, 1, At, B1); PG8_BAR;
            PG8_LDB(B0, 1, 0); PG8_SCHED; PG8_LDA(At, 1, 0); PG8_STAGE(PG8_SA(0, 1), a2 + hstep, voffA);
            PG8_WAIT_L(8); PG8_BAR; PG8_WAIT_L(0); PG8_MMA(0, 0, At, B0); PG8_BAR; PG8_SCHED;
            PG8_LDB(B1, 1, 1); PG8_STAGE(PG8_SB(1, 0), b3, voffB);
            PG8_BAR; PG8_WAIT_L(0); PG8_MMA(0, 1, At, B1); PG8_BAR;
            PG8_LDA(At, 1, 1); PG8_STAGE(PG8_SA(1, 0), a3, voffA);
            PG8_BAR; PG8_WAIT_L(0); PG8_MMA(1, 0, At, B0); PG8_BAR; PG8_SCHED;
            PG8_STAGE(PG8_SB(1, 1), b3 + hstep, voffB);
            PG8_WAIT_V(6); PG8_BAR; PG8_MMA(1, 1, At, B1); PG8_BAR;
            }
        }
        if constexpr (ALIGN_EPI) { if (wr == 0) PG8_BAR; }
        if constexpr (!Epi::AFTER_DRAIN) { E(acc, cur, wr, wc, fr, fq); S.done(cur); }
        if (!has_next) break;
#pragma unroll
        for (int a = 0; a < 2; ++a)
#pragma unroll
            for (int b = 0; b < 2; ++b)
#pragma unroll
                for (int m = 0; m < 4; ++m)
#pragma unroll
                    for (int n = 0; n < 2; ++n) acc[a][b][m][n] = (f32x4){0.f, 0.f, 0.f, 0.f};
        cur = nxt; cA = nA; cB = nB; ++ui;
        if constexpr (ALIGN_EPI) { if (wr == 1) PG8_BAR; }
    }
    PG8_WAIT_V(0);
    if constexpr (!ALIGN_EPI) { if (wr == 0) PG8_BAR; }
    PG8_BAR;
    if constexpr (Epi::AFTER_DRAIN) { E.fused(acc, cur, wr, wc, fr, fq, lds, wid, lane); S.done(cur); }
#undef PG8_SA
#undef PG8_SB
#undef PG8_STAGE
#undef PG8_LDA
#undef PG8_LDB
#undef PG8_MMA
#undef PG8_WAIT_V
#undef PG8_WAIT_L
#undef PG8_BAR
#undef PG8_SCHED
}
}
#define LAS __attribute__((address_space(3)))
typedef unsigned short bf16;
typedef unsigned u32x4 __attribute__((ext_vector_type(4)));
typedef unsigned u32x2 __attribute__((ext_vector_type(2)));
typedef float f32x4 __attribute__((ext_vector_type(4)));
typedef short bf16x8 __attribute__((ext_vector_type(8)));
typedef unsigned long long u64;

constexpr int NB = 4, T = 8192, D = 1024, M = NB * T, NPROJ = 3328, DFF = 2816, MEML = 256, MROWS = NB * MEML;
constexpr int C_QG = 0, C_KG = 256, C_VG = 512, C_GG = 1024, C_GK = 1536, C_QS = 1792, C_KS = 2304, C_VS = 2816;
constexpr float EPS = 1e-6f;
constexpr size_t MiB = 1u << 20;
constexpr size_t WS_WIN = 0, WS_WOUT = 7 * MiB, WS_WMQ = 9 * MiB, WS_WMKV = 11 * MiB, WS_WMO = 15 * MiB, WS_WGU = 17 * MiB, WS_WDN = 28 * MiB;
constexpr size_t WS_RS0 = 34 * MiB, WS_RSM = 34 * MiB + 128 * 1024, WS_SSQK = 34 * MiB + 256 * 1024, WS_SSQ1 = 35 * MiB, WS_SSQ2 = 37 * MiB, WS_SSQQ = 39 * MiB;
constexpr size_t WS_MEMB = 41 * MiB, WS_KV = 43 * MiB, WS_DEC = 47 * MiB, WS_CTL = 47 * MiB + 768 * 1024;
constexpr size_t WS_R0 = 48 * MiB, WS_R1 = 256 * MiB, WS_R2 = 320 * MiB, WS_R3 = 384 * MiB, WS_STB = 448 * MiB, WS_END = 480 * MiB;
static_assert(WS_R0 + (size_t)M * NPROJ * 2 <= WS_R1 && WS_WDN + (size_t)D * DFF * 2 <= WS_RS0, "ws map");
constexpr int LDS_BYTES = 147456;
constexpr int NTHR = 512;

__device__ __forceinline__ unsigned f2bf(float f) { unsigned u = __builtin_bit_cast(unsigned, f); return (u + 0x7fffu + ((u >> 16) & 1u)) >> 16; }
typedef float f32x2c __attribute__((ext_vector_type(2)));
typedef __bf16 bf16x2c __attribute__((ext_vector_type(2)));
__device__ __forceinline__ unsigned pk2(float lo, float hi) { const f32x2c v = {lo, hi}; const bf16x2c b = __builtin_convertvector(v, bf16x2c); return __builtin_bit_cast(unsigned, b); }
__device__ __forceinline__ float bf2f(unsigned short h) { return __builtin_bit_cast(float, (unsigned)h << 16); }
__device__ __forceinline__ float bflo(unsigned w) { return __builtin_bit_cast(float, w << 16); }
__device__ __forceinline__ float bfhi(unsigned w) { return __builtin_bit_cast(float, w & 0xffff0000u); }
__device__ __forceinline__ float wave_sum(float v) {
#pragma unroll
    for (int o = 1; o < 64; o <<= 1) v += __shfl_xor(v, o);
    return v;
}
__device__ __forceinline__ bf16x8 mk8(u32x4 w) { return __builtin_bit_cast(bf16x8, w); }
__device__ __forceinline__ bf16x8 mk8(u32x2 lo, u32x2 hi) { u32x4 w; w.x = lo.x; w.y = lo.y; w.z = hi.x; w.w = hi.y; return __builtin_bit_cast(bf16x8, w); }
__device__ __forceinline__ bf16x8 pk8(const f32x4 a, const f32x4 b) { u32x4 w; w.x = pk2(a[0], a[1]); w.y = pk2(a[2], a[3]); w.z = pk2(b[0], b[1]); w.w = pk2(b[2], b[3]); return __builtin_bit_cast(bf16x8, w); }
#define MFMA16(a, b, c) __builtin_amdgcn_mfma_f32_16x16x32_bf16((a), (b), (c), 0, 0, 0)
#define LDS_FENCE() asm volatile("s_waitcnt lgkmcnt(0)" ::: "memory")

#define XB_TMO      128
#define XB_XCNT(j)  (256  + 64 * (j))
#define XB_XSUB(j)  (1280 + 64 * (j))
#define XB_XGEN(j)  (2304 + 64 * (j))
#define XB_TOP      3328
#define XB_TOPGEN   3392
#define XCD_BAR_WORDS 3456
#define XB_SPIN_CAP (1u << 18)

__device__ __forceinline__ unsigned xb_ld(unsigned* p)              { return __hip_atomic_load(p, __ATOMIC_RELAXED, __HIP_MEMORY_SCOPE_AGENT); }
__device__ __forceinline__ unsigned xb_add(unsigned* p, unsigned v) { return __hip_atomic_fetch_add(p, v, __ATOMIC_RELAXED, __HIP_MEMORY_SCOPE_AGENT); }
__device__ __forceinline__ unsigned xb_xcc_id() { return (unsigned)__builtin_amdgcn_s_getreg((3 << 11) | 20) & 0xFu; }
#define XB_SPIN(cond, bar) do { unsigned _sp = 0; while (cond) { __builtin_amdgcn_s_sleep(1); \
    if ((++_sp & 255u) == 0u) { if (xb_ld(&(bar)[XB_TMO])) break; if (_sp > XB_SPIN_CAP) { atomicAdd(&(bar)[XB_TMO], 1u); break; } } } } while (0)

struct XcdBarrier {
    unsigned* bar; unsigned x;
    volatile LAS unsigned* st;
};

__device__ __forceinline__ XcdBarrier xcd_barrier_post(unsigned* bar, volatile LAS unsigned* st) {
    XcdBarrier b; b.bar = bar; b.x = xb_xcc_id(); b.st = st;
    if (threadIdx.x == 0) (void)xb_add(&bar[XB_XCNT(b.x)], 1u);
    return b;
}
__device__ __forceinline__ void xcd_barrier_complete(unsigned* bar, unsigned x, unsigned& nloc, unsigned& nx) {
    const unsigned G = gridDim.x * gridDim.y * gridDim.z;
    unsigned sum, cnt, mine, sp = 0u;
    for (;;) {
        sum = 0u; cnt = 0u; mine = 0u;
#pragma unroll
        for (unsigned j = 0; j < 16; ++j) { const unsigned c = xb_ld(&bar[XB_XCNT(j)]); sum += c; cnt += (c > 0u) ? 1u : 0u; mine = (j == x) ? c : mine; }
        if (sum == G) break;
        __builtin_amdgcn_s_sleep(1);
        if ((++sp & 255u) == 0u) { if (xb_ld(&bar[XB_TMO])) break; if (sp > XB_SPIN_CAP) { atomicAdd(&bar[XB_TMO], 1u); break; } }
    }
    nloc = mine > 0u ? mine : 1u; nx = cnt > 0u ? cnt : 1u;
}

__device__ __forceinline__ void xcd_barrier(const XcdBarrier& b) {
    asm volatile("s_waitcnt vmcnt(0)" ::: "memory");
    __syncthreads();
    if (threadIdx.x == 0) {
        unsigned* bar = b.bar;
        __builtin_amdgcn_s_waitcnt(0);
        unsigned nloc = b.st[0], nx = b.st[1];
        if (nloc == 0u) { xcd_barrier_complete(bar, b.x, nloc, nx); b.st[0] = nloc; b.st[1] = nx; }
        const unsigned old = xb_add(&bar[XB_XSUB(b.x)], 1u);
        const unsigned gen = old / nloc;
        if (old + 1u == (gen + 1u) * nloc) {
            __builtin_amdgcn_fence(__ATOMIC_RELEASE, "agent");
            asm volatile("s_waitcnt vmcnt(0)" ::: "memory");
            const unsigned og = xb_add(&bar[XB_TOP], 1u);
            const unsigned tg = og / nx;
            if (og + 1u == (tg + 1u) * nx) xb_add(&bar[XB_TOPGEN], 1u);
            else XB_SPIN(xb_ld(&bar[XB_TOPGEN]) == tg, bar);
            __builtin_amdgcn_fence(__ATOMIC_ACQUIRE, "agent");
            xb_add(&bar[XB_XGEN(b.x)], 1u);
            asm volatile("s_waitcnt vmcnt(0)" ::: "memory");
        } else {
            XB_SPIN(xb_ld(&bar[XB_XGEN(b.x)]) == gen, bar);
            __builtin_amdgcn_fence(__ATOMIC_ACQUIRE, "agent");
            asm volatile("s_waitcnt vmcnt(0)" ::: "memory");
        }
    }
    __syncthreads();
}

struct Args {
    const float *x, *mem, *mix_nw, *w_in, *w_gk_up, *b_gk, *gla_nw, *sb_nw, *w_out, *xat_nw, *mem_nw, *w_mq, *w_mkv, *mq_nw, *mk_nw, *w_mo, *ffn_nw, *w_gu, *w_dn;
    float* out; unsigned char* ws;
};

__device__ __forceinline__ void tr_item(const float* W, int ldw, int K, const float* kscale, float cscale, bf16* WT, int k0, int n0src, int drow0, LAS float* scr, int lane, const float* kscale2 = nullptr) {
#pragma unroll
    for (int i = 0; i < 32; ++i) { const int kk = 2 * i + (lane >> 5); const float ks = kscale2 ? ((k0 + kk) < 512 ? kscale[(k0 + kk) & 127] : kscale2[(k0 + kk) & 63]) : (kscale ? kscale[k0 + kk] : 1.0f);
        scr[kk * 33 + (lane & 31)] = __builtin_nontemporal_load(W + (size_t)(k0 + kk) * ldw + n0src + (lane & 31)) * (ks * cscale); }
    LDS_FENCE();
    const int c = lane & 7;
#pragma unroll
    for (int j = 0; j < 4; ++j) { const int n = (lane >> 3) + 8 * j; const LAS float* s = scr + (8 * c) * 33 + n;
        u32x4 o; o.x = pk2(s[0 * 33], s[1 * 33]); o.y = pk2(s[2 * 33], s[3 * 33]); o.z = pk2(s[4 * 33], s[5 * 33]); o.w = pk2(s[6 * 33], s[7 * 33]);
        *(u32x4*)(WT + (size_t)(drow0 + n) * K + k0 + 8 * c) = o; }
    LDS_FENCE();
}
__device__ __forceinline__ void row_to_bf16_rs(const float* xrow, bf16* orow, float* rs_out, int lane) {
    const f32x4* xr = (const f32x4*)xrow + lane;
    f32x4 v[4]; float s = 0.f;
#pragma unroll
    for (int j = 0; j < 4; ++j) { v[j] = xr[64 * j]; s += pg8::dot4(v[j]); }
    s = wave_sum(s);
    if (lane == 0) *rs_out = rsqrtf(s * (1.0f / 1024.0f) + EPS);
    u64* o8 = (u64*)orow + lane;
#pragma unroll
    for (int j = 0; j < 4; ++j) o8[64 * j] = (u64)pk2(v[j][0], v[j][1]) | ((u64)pk2(v[j][2], v[j][3]) << 32);
}

__device__ __forceinline__ void p0_do_item(const Args& a, int it, LAS float* scr, int lane) {
    unsigned char* ws = a.ws;
    constexpr int I_INA = 16 * 48, I_INB = 16 * 48, I_SQ = 16 * 32, I_MKV = 16 * 64, I_GU = 16 * 176, I_DN = 44 * 32;
        int r = it;
        if (r < I_INA) { const int kb = r / 48, nb = r % 48, n0 = 32 * nb; tr_item(a.w_in, 3088, 1024, a.mix_nw, n0 < 256 ? 0.125f : 1.0f, (bf16*)(ws + WS_WIN), 64 * kb, n0, n0, scr, lane); return; } r -= I_INA;
        if (r < I_INB) { const int kb = r / 48, nb = r % 48, n0 = 32 * nb; tr_item(a.w_in, 3088, 1024, a.mix_nw, n0 < 512 ? 0.125f * 1.44269504f : 1.0f, (bf16*)(ws + WS_WIN), 64 * kb, 1552 + n0, 1792 + n0, scr, lane); return; } r -= I_INB;
        if (r < I_SQ) { const int kb = r / 32, nb = r % 32; tr_item(a.w_out, 1024, 1024, a.gla_nw, 1.0f, (bf16*)(ws + WS_WOUT), 64 * kb, 32 * nb, 32 * nb, scr, lane, a.sb_nw); return; } r -= I_SQ;
        if (r < I_SQ) { const int kb = r / 32, nb = r % 32; tr_item(a.w_mq, 1024, 1024, a.xat_nw, 1.0f, (bf16*)(ws + WS_WMQ), 64 * kb, 32 * nb, 32 * nb, scr, lane); return; } r -= I_SQ;
        if (r < I_SQ) { const int kb = r / 32, nb = r % 32; tr_item(a.w_mo, 1024, 1024, nullptr, 1.0f, (bf16*)(ws + WS_WMO), 64 * kb, 32 * nb, 32 * nb, scr, lane); return; } r -= I_SQ;
        if (r < I_MKV) { const int kb = r / 64, nb = r % 64; tr_item(a.w_mkv, 2048, 1024, a.mem_nw, 1.0f, (bf16*)(ws + WS_WMKV), 64 * kb, 32 * nb, 32 * nb, scr, lane); return; } r -= I_MKV;
        if (r < I_GU) { const int kb = r / 176, nb = r % 176, n0 = 32 * nb; const int j0 = n0 < DFF ? n0 : n0 - DFF; const int dr = 256 * (j0 / 128) + (j0 % 128) + (n0 < DFF ? 0 : 128);
            tr_item(a.w_gu, 2 * DFF, 1024, a.ffn_nw, 1.0f, (bf16*)(ws + WS_WGU), 64 * kb, n0, dr, scr, lane); return; } r -= I_GU;
        { const int kb = r / 32, nb = r % 32; tr_item(a.w_dn, 1024, DFF, nullptr, 1.0f, (bf16*)(ws + WS_WDN), 64 * kb, 32 * nb, 32 * nb, scr, lane); }
}
__device__ __forceinline__ void p0_prologue(const Args& a, LAS unsigned char* lds, int wid, int lane, int G) {
    unsigned char* ws = a.ws;
    LAS float* scr = (LAS float*)(lds + wid * 16384);
    const int gw = blockIdx.x * 8 + wid, NGW = G * 8;
    constexpr int NITEMS = 16 * 48 * 2 + 3 * 16 * 32 + 16 * 64 + 16 * 176 + 44 * 32;
    {
        int it = gw, m4 = gw * 4;
        while (it < NITEMS || m4 < M) {
            const bool hx = m4 < M;
            f32x4 v[4][4];
            if (hx) {
#pragma unroll
                for (int r = 0; r < 4; ++r) { const f32x4* xr = (const f32x4*)(a.x + (size_t)(m4 + r) * D) + lane;
#pragma unroll
                    for (int jj = 0; jj < 4; ++jj) v[r][jj] = __builtin_nontemporal_load(xr + 64 * jj); }
            }
            if (it < NITEMS) { p0_do_item(a, it, scr, lane); it += NGW; }
            if (hx) {
                float s[4];
#pragma unroll
                for (int r = 0; r < 4; ++r) { float t = 0.f;
#pragma unroll
                    for (int jj = 0; jj < 4; ++jj) t += pg8::dot4(v[r][jj]);
                    s[r] = wave_sum(t); }
#pragma unroll
                for (int r = 0; r < 4; ++r) { if (lane == 0) ((float*)(ws + WS_RS0))[m4 + r] = rsqrtf(s[r] * (1.0f / 1024.0f) + EPS);
                    u64* o8 = (u64*)((bf16*)(ws + WS_R2) + (size_t)(m4 + r) * D) + lane;
#pragma unroll
                    for (int jj = 0; jj < 4; ++jj) o8[64 * jj] = (u64)pk2(v[r][jj][0], v[r][jj][1]) | ((u64)pk2(v[r][jj][2], v[r][jj][3]) << 32); }
                m4 += NGW * 4;
            }
        }
    }
    {
        bf16* WT = (bf16*)(ws + WS_WIN);
        for (int it = blockIdx.x * NTHR + threadIdx.x; it < 256 * 512; it += G * NTHR) {
            const int j = it & 255, k0 = (it >> 8) * 2;
            float up[16];
#pragma unroll
            for (int r = 0; r < 16; ++r) up[r] = a.w_gk_up[r * 256 + j];
            float o[2];
#pragma unroll
            for (int e = 0; e < 2; ++e) { const f32x4* wr_ = (const f32x4*)(a.w_in + (size_t)(k0 + e) * 3088 + 1536); float s = 0.f;
#pragma unroll
                for (int r4 = 0; r4 < 4; ++r4) { const f32x4 wv = wr_[r4]; s += wv[0] * up[4 * r4] + wv[1] * up[4 * r4 + 1] + wv[2] * up[4 * r4 + 2] + wv[3] * up[4 * r4 + 3]; }
                o[e] = s * a.mix_nw[k0 + e]; }
            *(unsigned*)(WT + (size_t)(1536 + j) * 1024 + k0) = pk2(o[0], o[1]);
        }
    }
    for (int m = gw; m < MROWS; m += NGW) row_to_bf16_rs(a.mem + (size_t)m * D, (bf16*)(ws + WS_MEMB) + (size_t)m * D, (float*)(ws + WS_RSM) + m, lane);
}

constexpr int GL_HALF = 73728, GL_BF = 0, GL_KDT = 16640, GL_VT = 25856, GL_QE = 44288, GL_KE = 53504, GL_QB = 62720, GL_TOT = 71936;
struct GlaRaw { float gk[16]; u32x4 q[2]; u32x4 k[2]; u32x4 v[4]; };
template <bool WITHQ, int PART> __device__ __forceinline__ void gla_load_raw(GlaRaw& r, const bf16* PROJ, int unit, int hw, int th) {
    const int c = 2 * unit + hw, bh = c >> 7, n = c & 127, b = bh >> 2, h = bh & 3;
    const size_t row0 = (size_t)b * T + (size_t)n * 64;
    const int d = th & 63, seg = th >> 6, t = th >> 2, dseg = (th & 3) * 16;
    const bf16* gkp = PROJ + row0 * NPROJ + C_GK + h * 64;
    if (PART == 0) {
#pragma unroll
        for (int i = 0; i < 16; ++i) r.gk[i] = bf2f(gkp[(size_t)(16 * seg + i) * NPROJ + d]);
        return;
    }
    const bf16* kp = PROJ + (row0 + t) * NPROJ + C_KG + h * 64 + dseg; r.k[0] = *(const u32x4*)kp; r.k[1] = *(const u32x4*)(kp + 8);
    if (WITHQ) { const bf16* qp = PROJ + (row0 + t) * NPROJ + C_QG + h * 64 + dseg; r.q[0] = *(const u32x4*)qp; r.q[1] = *(const u32x4*)(qp + 8); }
    const bf16* vp = PROJ + (row0 + t) * NPROJ + C_VG + h * 128 + (th & 3) * 32;
#pragma unroll
    for (int i = 0; i < 4; ++i) r.v[i] = *(const u32x4*)(vp + 8 * i);
}
__device__ __forceinline__ void gla_cumsum_r(LAS float* Bf, LAS float* Tot, const GlaRaw& r, int th) {
    const int d = th & 63, seg = th >> 6;
    float acc[16]; float run = 0.f;
#pragma unroll
    for (int i = 0; i < 16; ++i) { run += r.gk[i]; acc[i] = run; }
    Tot[seg * 64 + d] = run;
    __syncthreads();
    float off = 0.f;
#pragma unroll
    for (int s = 0; s < 3; ++s) if (s < seg) off += Tot[s * 64 + d];
#pragma unroll
    for (int i = 0; i < 16; ++i) Bf[(16 * seg + i) * 65 + d] = acc[i] + off;
    __syncthreads();
}
__device__ __forceinline__ void gla_store_vt(LAS bf16* VT, const GlaRaw& r, int t, int dvseg) {
#pragma unroll
    for (int i = 0; i < 4; ++i)
#pragma unroll
        for (int e = 0; e < 4; ++e) { VT[(dvseg + 8 * i + 2 * e) * 72 + t] = (bf16)(r.v[i][e] & 0xffffu); VT[(dvseg + 8 * i + 2 * e + 1) * 72 + t] = (bf16)(r.v[i][e] >> 16); }
}
__device__ __forceinline__ void gla_pass_a_all(const Args& a, LAS unsigned char* lds, int G) {
    const int tid = threadIdx.x, wid = tid >> 6, lane = tid & 63, hw = wid >> 2, wq = wid & 3, th = tid & 255, fr = lane & 15, fq = lane >> 4;
    const bf16* PROJ = (const bf16*)(a.ws + WS_R0); bf16* ST = (bf16*)(a.ws + WS_R3); float* DEC = (float*)(a.ws + WS_DEC);
    LAS unsigned char* L = lds + hw * GL_HALF;
    LAS float* Bf = (LAS float*)(L + GL_BF); LAS float* Tot = (LAS float*)(L + GL_TOT); LAS bf16* KdT = (LAS bf16*)(L + GL_KDT); LAS bf16* VT = (LAS bf16*)(L + GL_VT);
    int unit = blockIdx.x; if (unit >= 1024) return;
    GlaRaw r; gla_load_raw<false, 0>(r, PROJ, unit, hw, th);
    for (; unit < 1024; unit += G) {
        const int c = 2 * unit + hw;
        gla_load_raw<false, 1>(r, PROJ, unit, hw, th);
        gla_cumsum_r(Bf, Tot, r, th);
        {
            const int t = th >> 2, dseg = (th & 3) * 16;
#pragma unroll
            for (int i = 0; i < 16; ++i) { const int d = dseg + i; const unsigned w = (i < 8) ? r.k[0][(i & 7) >> 1] : r.k[1][(i & 7) >> 1]; const float kv = (i & 1) ? bfhi(w) : bflo(w);
                KdT[d * 72 + t] = (bf16)f2bf(kv * __expf(Bf[63 * 65 + d] - Bf[t * 65 + d])); }
            gla_store_vt(VT, r, t, (th & 3) * 32);
            if (th < 64) DEC[(size_t)c * 64 + th] = __expf(Bf[63 * 65 + th]);
        }
        __syncthreads();
        if (unit + G < 1024) gla_load_raw<false, 0>(r, PROJ, unit + G, hw, th);
#pragma unroll
        for (int dvi = 0; dvi < 2; ++dvi) {
            const int dvb = 2 * wq + dvi;
            const bf16x8 a0 = *(const LAS bf16x8*)(VT + (16 * dvb + fr) * 72 + 8 * fq), a1 = *(const LAS bf16x8*)(VT + (16 * dvb + fr) * 72 + 32 + 8 * fq);
#pragma unroll
            for (int dkb = 0; dkb < 4; ++dkb) {
                const bf16x8 b0 = *(const LAS bf16x8*)(KdT + (16 * dkb + fr) * 72 + 8 * fq), b1 = *(const LAS bf16x8*)(KdT + (16 * dkb + fr) * 72 + 32 + 8 * fq);
                f32x4 acc = {0.f, 0.f, 0.f, 0.f};
                acc = MFMA16(a0, b0, acc); acc = MFMA16(a1, b1, acc);
#pragma unroll
                for (int rr = 0; rr < 4; ++rr) ST[(size_t)c * 8192 + (16 * dvb + 4 * fq + rr) * 64 + 16 * dkb + fr] = (bf16)f2bf(acc[rr]);
            }
        }
        __syncthreads();
    }
}
typedef float f32x2s __attribute__((ext_vector_type(2)));
__device__ __forceinline__ void gla_scan_w(const Args& a, int G, int t256) {
    const unsigned* UT = (const unsigned*)(a.ws + WS_R3); const float* DEC = (const float*)(a.ws + WS_DEC); unsigned* STB = (unsigned*)(a.ws + WS_STB);
    for (int base = blockIdx.x * 512; base < 16 * 8192; base += G * 512) {
        const int bh = base >> 13, e0 = (base & 8191) + 2 * t256, dk = e0 & 63;
        float S0 = 0.f, S1 = 0.f;
        for (int n0 = 0; n0 < 128; n0 += 32) {
            unsigned u[32]; f32x2s dc[32];
#pragma unroll
            for (int i = 0; i < 32; ++i) { const size_t c = (size_t)bh * 128 + n0 + i; dc[i] = *(const f32x2s*)(DEC + c * 64 + dk); u[i] = UT[(c * 8192 + e0) >> 1]; }
#pragma unroll
            for (int i = 0; i < 32; ++i) { const size_t c = (size_t)bh * 128 + n0 + i;
                STB[(c * 8192 + e0) >> 1] = pk2(S0, S1); S0 = dc[i][0] * S0 + bflo(u[i]); S1 = dc[i][1] * S1 + bfhi(u[i]); }
        }
    }
}
__device__ __forceinline__ void gla_pass_c_all(const Args& a, LAS unsigned char* lds, int G) {
    const int tid = threadIdx.x, wid = tid >> 6, lane = tid & 63, hw = wid >> 2, ib = wid & 3, th = tid & 255, fr = lane & 15, fq = lane >> 4;
    const bf16* PROJ = (const bf16*)(a.ws + WS_R0); const bf16* STB = (const bf16*)(a.ws + WS_STB); bf16* MIX = (bf16*)(a.ws + WS_R1);
    LAS unsigned char* L = lds + hw * GL_HALF;
    LAS float* Bf = (LAS float*)(L + GL_BF); LAS float* Tot = (LAS float*)(L + GL_TOT); LAS bf16* VT = (LAS bf16*)(L + GL_VT);
    LAS bf16* QE = (LAS bf16*)(L + GL_QE); LAS bf16* KE = (LAS bf16*)(L + GL_KE); LAS bf16* QB = (LAS bf16*)(L + GL_QB);
    int unit = blockIdx.x; if (unit >= 1024) return;
    GlaRaw r; gla_load_raw<true, 0>(r, PROJ, unit, hw, th);
    for (; unit < 1024; unit += G) {
        const int c = 2 * unit + hw, bh = c >> 7, n = c & 127, b = bh >> 2, h = bh & 3;
        const size_t row0 = (size_t)b * T + (size_t)n * 64;
        const size_t tok = row0 + 16 * ib + fr;
        gla_load_raw<true, 1>(r, PROJ, unit, hw, th);
        u32x2 gw[8];
#pragma unroll
        for (int dvb = 0; dvb < 8; ++dvb) gw[dvb] = *(const u32x2*)(PROJ + tok * NPROJ + C_GG + h * 128 + 16 * dvb + 4 * fq);
        gla_cumsum_r(Bf, Tot, r, th);
        {
            const int t = th >> 2, dseg = (th & 3) * 16;
            float qe[16], ke[16], qb[16];
#pragma unroll
            for (int i = 0; i < 16; ++i) { const int d = dseg + i; const unsigned wq_ = (i < 8) ? r.q[0][(i & 7) >> 1] : r.q[1][(i & 7) >> 1], wk_ = (i < 8) ? r.k[0][(i & 7) >> 1] : r.k[1][(i & 7) >> 1];
                const float qv = (i & 1) ? bfhi(wq_) : bflo(wq_), kv = (i & 1) ? bfhi(wk_) : bflo(wk_);
                const float bt = Bf[t * 65 + d], br = Bf[31 * 65 + d]; const float dl = fminf(fmaxf(bt - br, -80.f), 80.f);
                qe[i] = qv * __expf(dl); ke[i] = kv * __expf(-dl); qb[i] = qv * __expf(bt); }
#pragma unroll
            for (int v = 0; v < 2; ++v) {
                u32x4 w;
                w.x = pk2(qe[8 * v + 0], qe[8 * v + 1]); w.y = pk2(qe[8 * v + 2], qe[8 * v + 3]); w.z = pk2(qe[8 * v + 4], qe[8 * v + 5]); w.w = pk2(qe[8 * v + 6], qe[8 * v + 7]); *(LAS u32x4*)(QE + t * 72 + dseg + 8 * v) = w;
                w.x = pk2(ke[8 * v + 0], ke[8 * v + 1]); w.y = pk2(ke[8 * v + 2], ke[8 * v + 3]); w.z = pk2(ke[8 * v + 4], ke[8 * v + 5]); w.w = pk2(ke[8 * v + 6], ke[8 * v + 7]); *(LAS u32x4*)(KE + t * 72 + dseg + 8 * v) = w;
                w.x = pk2(qb[8 * v + 0], qb[8 * v + 1]); w.y = pk2(qb[8 * v + 2], qb[8 * v + 3]); w.z = pk2(qb[8 * v + 4], qb[8 * v + 5]); w.w = pk2(qb[8 * v + 6], qb[8 * v + 7]); *(LAS u32x4*)(QB + t * 72 + dseg + 8 * v) = w;
            }
            gla_store_vt(VT, r, t, (th & 3) * 32);
        }
        bf16x8 sfr[8][2];
#pragma unroll
        for (int dvb = 0; dvb < 8; ++dvb) { const bf16* sp = STB + (size_t)c * 8192 + (16 * dvb + fr) * 64 + 8 * fq; sfr[dvb][0] = *(const bf16x8*)sp; sfr[dvb][1] = *(const bf16x8*)(sp + 32); }
        __syncthreads();
        if (unit + G < 1024) gla_load_raw<true, 0>(r, PROJ, unit + G, hw, th);
        {
            f32x4 accA[4];
            const bf16x8 qe0 = *(const LAS bf16x8*)(QE + (16 * ib + fr) * 72 + 8 * fq), qe1 = *(const LAS bf16x8*)(QE + (16 * ib + fr) * 72 + 32 + 8 * fq);
#pragma unroll
            for (int jb = 0; jb < 4; ++jb) {
                accA[jb] = (f32x4){0.f, 0.f, 0.f, 0.f};
                if (jb <= ib) {
                    const bf16x8 ke0 = *(const LAS bf16x8*)(KE + (16 * jb + fr) * 72 + 8 * fq), ke1 = *(const LAS bf16x8*)(KE + (16 * jb + fr) * 72 + 32 + 8 * fq);
                    accA[jb] = MFMA16(ke0, qe0, accA[jb]); accA[jb] = MFMA16(ke1, qe1, accA[jb]);
                    if (jb == ib) {
#pragma unroll
                        for (int rr = 0; rr < 4; ++rr) if (4 * fq + rr > fr) accA[jb][rr] = 0.f;
                    }
                }
            }
            const bf16x8 P0 = pk8(accA[0], accA[1]), P1 = pk8(accA[2], accA[3]);
            const bf16x8 qb0 = *(const LAS bf16x8*)(QB + (16 * ib + fr) * 72 + 8 * fq), qb1 = *(const LAS bf16x8*)(QB + (16 * ib + fr) * 72 + 32 + 8 * fq);
            f32x4 o[8]; float ssq = 0.f;
#pragma unroll
            for (int dvb = 0; dvb < 8; ++dvb) {
                f32x4 acc = {0.f, 0.f, 0.f, 0.f};
                const LAS bf16* vrow = VT + (16 * dvb + fr) * 72 + 4 * fq;
                { const bf16x8 av = mk8(*(const LAS u32x2*)(vrow), *(const LAS u32x2*)(vrow + 16)); acc = MFMA16(av, P0, acc); }
                if (ib >= 2) { const bf16x8 av = mk8(*(const LAS u32x2*)(vrow + 32), *(const LAS u32x2*)(vrow + 48)); acc = MFMA16(av, P1, acc); }
                acc = MFMA16(sfr[dvb][0], qb0, acc);
                acc = MFMA16(sfr[dvb][1], qb1, acc);
                o[dvb] = acc; ssq += pg8::dot4(acc);
            }
            ssq += __shfl_xor(ssq, 16); ssq += __shfl_xor(ssq, 32);
            const float rs = rsqrtf(ssq * (1.0f / 128.0f) + EPS);
#pragma unroll
            for (int dvb = 0; dvb < 8; ++dvb) {
                const int dv = 16 * dvb + 4 * fq;
                const float g0 = bflo(gw[dvb].x), g1 = bfhi(gw[dvb].x), g2 = bflo(gw[dvb].y), g3 = bfhi(gw[dvb].y);
                u32x2 w; w.x = pk2(o[dvb][0] * rs * pg8::silu_f(g0), o[dvb][1] * rs * pg8::silu_f(g1)); w.y = pk2(o[dvb][2] * rs * pg8::silu_f(g2), o[dvb][3] * rs * pg8::silu_f(g3));
                *(u32x2*)(MIX + tok * 1024 + h * 128 + dv) = w;
            }
        }
        __syncthreads();
    }
}
constexpr float SB_STOP = -57.7f;
__device__ __forceinline__ void sb_pair(const Args& a, int pair, LAS bf16* Vl, int lane) {
    const int fr = lane & 15, fq = lane >> 4;
    const bf16* PROJ = (const bf16*)(a.ws + WS_R0); bf16* MIX = (bf16*)(a.ws + WS_R1);
    const int bh = pair >> 8, jt = pair & 255, b = bh >> 3, h = bh & 7, t0 = 32 * jt;
    const size_t rowb = (size_t)b * T;
    bf16x8 q0[2], q1[2];
#pragma unroll
    for (int u = 0; u < 2; ++u) { const bf16* qp = PROJ + (rowb + t0 + 16 * u + fr) * NPROJ + C_QS + h * 64 + 8 * fq; q0[u] = *(const bf16x8*)qp; q1[u] = *(const bf16x8*)(qp + 32); }
    bf16x8 Tf[2];
#pragma unroll
    for (int bb = 0; bb < 2; ++bb)
#pragma unroll
        for (int jj = 0; jj < 8; ++jj) { const int j = (jj < 4) ? 4 * fq + jj : 16 + 4 * fq + (jj - 4); Tf[bb][jj] = (j > 16 * bb + fr) ? (short)0x3F80 : (short)0; }
    f32x4 o[2][4];
#pragma unroll
    for (int u = 0; u < 2; ++u)
#pragma unroll
        for (int c = 0; c < 4; ++c) o[u][c] = (f32x4){0.f, 0.f, 0.f, 0.f};
    float carry[2] = {0.f, 0.f};
    int kt0 = t0;
    const int vs = lane >> 1, vhalf = lane & 1;
    const bf16* vbase = PROJ + rowb * NPROJ + C_VS + h * 64 + 32 * vhalf;
    const bf16* kbase = PROJ + rowb * NPROJ + C_KS + h * 64 + 8 * fq;
    u32x4 vcur[4]; bf16x8 kcur[2][2];
#pragma unroll
    for (int i = 0; i < 4; ++i) vcur[i] = *(const u32x4*)(vbase + (size_t)(kt0 + vs) * NPROJ + 8 * i);
#pragma unroll
    for (int bb = 0; bb < 2; ++bb) { const bf16* kp = kbase + (size_t)(kt0 + 16 * bb + fr) * NPROJ; kcur[bb][0] = *(const bf16x8*)kp; kcur[bb][1] = *(const bf16x8*)(kp + 32); }
    for (;;) {
#pragma unroll
        for (int i = 0; i < 4; ++i)
#pragma unroll
            for (int e = 0; e < 4; ++e) { Vl[(32 * vhalf + 8 * i + 2 * e) * 36 + vs] = (bf16)(vcur[i][e] & 0xffffu); Vl[(32 * vhalf + 8 * i + 2 * e + 1) * 36 + vs] = (bf16)(vcur[i][e] >> 16); }
        f32x4 S[2][2];
#pragma unroll
        for (int u = 0; u < 2; ++u)
#pragma unroll
            for (int bb = 0; bb < 2; ++bb) { S[u][bb] = (f32x4){0.f, 0.f, 0.f, 0.f}; S[u][bb] = MFMA16(kcur[bb][0], q0[u], S[u][bb]); S[u][bb] = MFMA16(kcur[bb][1], q1[u], S[u][bb]); }
        { const int kn = kt0 >= 32 ? kt0 - 32 : 0;
#pragma unroll
          for (int i = 0; i < 4; ++i) vcur[i] = *(const u32x4*)(vbase + (size_t)(kn + vs) * NPROJ + 8 * i);
#pragma unroll
          for (int bb = 0; bb < 2; ++bb) { const bf16* kp = kbase + (size_t)(kn + 16 * bb + fr) * NPROJ; kcur[bb][0] = *(const bf16x8*)kp; kcur[bb][1] = *(const bf16x8*)(kp + 32); } }
        bf16x8 P[2]; float tot[2];
#pragma unroll
        for (int u = 0; u < 2; ++u) {
            const int t = t0 + 16 * u + fr;
            f32x4 Lm[2], lb[2]; float tt = 0.f;
#pragma unroll
            for (int bb = 0; bb < 2; ++bb)
#pragma unroll
                for (int r = 0; r < 4; ++r) { const bool ok = (kt0 + 16 * bb + 4 * fq + r) < t; const float z = S[u][bb][r];
                    const float sp = fmaxf(z, 0.f) + __builtin_amdgcn_logf(1.0f + __builtin_amdgcn_exp2f(-fabsf(z)));
                    Lm[bb][r] = ok ? -sp : 0.f; lb[bb][r] = ok ? (z - sp) : -1.0e30f; tt += Lm[bb][r]; }
            const bf16x8 Lhi = pk8(Lm[0], Lm[1]);
            f32x4 d0, d1;
            { const u32x4 w = __builtin_bit_cast(u32x4, Lhi);
              d0[0] = Lm[0][0] - bflo(w.x); d0[1] = Lm[0][1] - bfhi(w.x); d0[2] = Lm[0][2] - bflo(w.y); d0[3] = Lm[0][3] - bfhi(w.y);
              d1[0] = Lm[1][0] - bflo(w.z); d1[1] = Lm[1][1] - bfhi(w.z); d1[2] = Lm[1][2] - bflo(w.w); d1[3] = Lm[1][3] - bfhi(w.w); }
            const bf16x8 Llo = pk8(d0, d1);
            f32x4 R[2];
#pragma unroll
            for (int bb = 0; bb < 2; ++bb) { R[bb] = (f32x4){0.f, 0.f, 0.f, 0.f}; R[bb] = MFMA16(Tf[bb], Lhi, R[bb]); R[bb] = MFMA16(Tf[bb], Llo, R[bb]); }
            tt += __shfl_xor(tt, 16); tt += __shfl_xor(tt, 32);
            f32x4 pp[2];
#pragma unroll
            for (int bb = 0; bb < 2; ++bb)
#pragma unroll
                for (int r = 0; r < 4; ++r) pp[bb][r] = __builtin_amdgcn_exp2f(lb[bb][r] + R[bb][r] + carry[u]);
            P[u] = pk8(pp[0], pp[1]); tot[u] = tt;
        }
        LDS_FENCE();
#pragma unroll
        for (int c = 0; c < 4; ++c) { const LAS bf16* vrow = Vl + (16 * c + fr) * 36 + 4 * fq;
            const bf16x8 av = mk8(*(const LAS u32x2*)(vrow), *(const LAS u32x2*)(vrow + 16)); o[0][c] = MFMA16(av, P[0], o[0][c]); o[1][c] = MFMA16(av, P[1], o[1][c]); }
        LDS_FENCE();
        carry[0] += tot[0]; carry[1] += tot[1];
        if (kt0 == 0 || __all(fmaxf(carry[0], carry[1]) < SB_STOP)) break;
        kt0 -= 32;
    }
#pragma unroll
    for (int u = 0; u < 2; ++u) {
        float ssq = 0.f;
#pragma unroll
        for (int c = 0; c < 4; ++c) ssq += pg8::dot4(o[u][c]);
        ssq += __shfl_xor(ssq, 16); ssq += __shfl_xor(ssq, 32);
        const float rs = rsqrtf(ssq * (1.0f / 64.0f) + EPS);
#pragma unroll
        for (int c = 0; c < 4; ++c) { const int dv = 16 * c + 4 * fq;
            u32x2 w; w.x = pk2(o[u][c][0] * rs, o[u][c][1] * rs); w.y = pk2(o[u][c][2] * rs, o[u][c][3] * rs);
            *(u32x2*)(MIX + (rowb + t0 + 16 * u + fr) * 1024 + 512 + h * 64 + dv) = w; }
    }
}

constexpr int XPK = 272, XPV = 260;
__device__ __forceinline__ void xattn_unit(const Args& a, LAS unsigned char* lds, int unit) {
    const int tid = threadIdx.x, wid = tid >> 6, lane = tid & 63, fr = lane & 15, fq = lane >> 4;
    const bf16* KV = (const bf16*)(a.ws + WS_KV); const float* SSQK = (const float*)(a.ws + WS_SSQK); const float* SSQQ = (const float*)(a.ws + WS_SSQQ);
    const bf16* Q = (const bf16*)(a.ws + WS_R1); bf16* XO = (bf16*)(a.ws + WS_R3);
    const int tile = unit >> 2, h = unit & 3, b = tile >> 5;
    const size_t row0 = (size_t)tile * 256;
    LAS bf16* IM = (LAS bf16*)lds;
    {
        const int m = tid >> 1, half = tid & 1; const size_t kr = (size_t)(b * MEML + m);
        const f32x4 pq = *(const f32x4*)(SSQK + kr * 16 + h * 4);
        const float rk = rsqrtf(pg8::hsum4(pq) * (1.0f / 256.0f) + EPS) * 0.0625f;
        const bf16* kp = KV + kr * 2048 + h * 256 + 128 * half;
#pragma unroll
        for (int i = 0; i < 16; ++i) { const int d = 128 * half + 8 * i; const u32x4 w = *(const u32x4*)(kp + 8 * i);
            u32x4 o; o.x = pk2(bflo(w.x) * rk, bfhi(w.x) * rk); o.y = pk2(bflo(w.y) * rk, bfhi(w.y) * rk);
            o.z = pk2(bflo(w.z) * rk, bfhi(w.z) * rk); o.w = pk2(bflo(w.w) * rk, bfhi(w.w) * rk);
            *(LAS u32x4*)(IM + m * XPK + d) = o; }
    }
    __syncthreads();
    bf16x8 Pf[2][8];
#pragma unroll
    for (int qb = 0; qb < 2; ++qb) {
        const size_t tok = row0 + 32 * wid + 16 * qb + fr;
        bf16x8 Qf[8];
#pragma unroll
        for (int ks = 0; ks < 8; ++ks) Qf[ks] = *(const bf16x8*)(Q + tok * 1024 + h * 256 + 32 * ks + 8 * fq);
        const f32x4 pq = *(const f32x4*)(SSQQ + tok * 16 + h * 4);
        const float rq = rsqrtf(pg8::hsum4(pq) * (1.0f / 256.0f) + EPS);
        f32x4 S[16]; float mx = -3.0e38f;
#pragma unroll
        for (int mb = 0; mb < 16; ++mb) { f32x4 acc = {0.f, 0.f, 0.f, 0.f};
#pragma unroll
            for (int ks = 0; ks < 8; ++ks) { const bf16x8 kf = *(const LAS bf16x8*)(IM + (16 * mb + fr) * XPK + 32 * ks + 8 * fq); acc = MFMA16(kf, Qf[ks], acc); }
            acc = acc * rq; S[mb] = acc; mx = fmaxf(mx, fmaxf(fmaxf(acc[0], acc[1]), fmaxf(acc[2], acc[3]))); }
        mx = fmaxf(mx, __shfl_xor(mx, 16)); mx = fmaxf(mx, __shfl_xor(mx, 32));
        float sum = 0.f;
#pragma unroll
        for (int mb = 0; mb < 16; ++mb) {
#pragma unroll
            for (int r = 0; r < 4; ++r) { const float e = __expf(S[mb][r] - mx); S[mb][r] = e; sum += e; } }
        sum += __shfl_xor(sum, 16); sum += __shfl_xor(sum, 32);
        const float inv = 1.0f / sum;
#pragma unroll
        for (int kp = 0; kp < 8; ++kp) Pf[qb][kp] = pk8(S[2 * kp] * inv, S[2 * kp + 1] * inv);
        __builtin_amdgcn_sched_barrier(0);
    }
    __syncthreads();
    {
        const int m = tid >> 1, half = tid & 1; const bf16* vp = KV + (size_t)(b * MEML + m) * 2048 + 1024 + h * 256 + 128 * half;
#pragma unroll
        for (int i = 0; i < 16; ++i) { const u32x4 w = *(const u32x4*)(vp + 8 * i); const int dv = 128 * half + 8 * i;
#pragma unroll
            for (int e = 0; e < 4; ++e) { IM[(dv + 2 * e) * XPV + m] = (bf16)(w[e] & 0xffffu); IM[(dv + 2 * e + 1) * XPV + m] = (bf16)(w[e] >> 16); } }
    }
    __syncthreads();
    {
        const size_t tok0 = row0 + 32 * wid + fr, tok1 = tok0 + 16;
#pragma unroll
        for (int dvb = 0; dvb < 16; ++dvb) { f32x4 acc0 = {0.f, 0.f, 0.f, 0.f}, acc1 = {0.f, 0.f, 0.f, 0.f};
            const LAS bf16* vrow = IM + (16 * dvb + fr) * XPV + 4 * fq;
#pragma unroll
            for (int kp = 0; kp < 8; ++kp) { const bf16x8 av = mk8(*(const LAS u32x2*)(vrow + 32 * kp), *(const LAS u32x2*)(vrow + 32 * kp + 16)); acc0 = MFMA16(av, Pf[0][kp], acc0); acc1 = MFMA16(av, Pf[1][kp], acc1); }
            u32x2 w; w.x = pk2(acc0[0], acc0[1]); w.y = pk2(acc0[2], acc0[3]);
            *(u32x2*)(XO + tok0 * 1024 + h * 256 + 16 * dvb + 4 * fq) = w;
            w.x = pk2(acc1[0], acc1[1]); w.y = pk2(acc1[2], acc1[3]);
            *(u32x2*)(XO + tok1 * 1024 + h * 256 + 16 * dvb + 4 * fq) = w; __builtin_amdgcn_sched_barrier(0); }
    }
    __syncthreads();
}

__global__ void __launch_bounds__(NTHR, 2) hybrid_fwd(Args a) {
    extern __shared__ __attribute__((aligned(16))) unsigned char lds_raw[];
    LAS unsigned char* lds = (LAS unsigned char*)lds_raw;
    cg::grid_group grid = cg::this_grid();
    volatile LAS unsigned* bst = (volatile LAS unsigned*)(lds + 146688);
    if (threadIdx.x < 2) bst[threadIdx.x] = 0u;
    __syncthreads();
    XcdBarrier bar = xcd_barrier_post((unsigned*)(a.ws + WS_CTL), bst);
#define GRID_SYNC() do { xcd_barrier(bar); } while (0)
    if (a.ws == nullptr) grid.sync();
    const int tid = threadIdx.x, wid = __builtin_amdgcn_readfirstlane(tid >> 6), lane = tid & 63, G = gridDim.x;
    unsigned char* ws = a.ws;
    bf16* PROJ = (bf16*)(ws + WS_R0); bf16* R1 = (bf16*)(ws + WS_R1); bf16* R2 = (bf16*)(ws + WS_R2);

    p0_prologue(a, lds, wid, lane, G);
    GRID_SYNC();
    {
        pg8::Gemm g{R2, (const bf16*)(ws + WS_WIN), M, NPROJ, D}; pg8::StaticOrder S; S.init(M, NPROJ, G, (int)blockIdx.x);
        pg8::EpiScale<0> E{PROJ, NPROJ, (const float*)(ws + WS_RS0), a.b_gk, nullptr, nullptr};
        pg8::gemm_phase<pg8::EpiScale<0>, pg8::StaticOrder, true, true>(lds, g, S, E);
    }
    {
        pg8::Gemm g{(const bf16*)(ws + WS_MEMB), (const bf16*)(ws + WS_WMKV), MROWS, 2048, D}; pg8::StaticOrder S; S.init(MROWS, 2048, G, (int)((blockIdx.x + G / 2) % G));
        pg8::EpiScale<1> E{(bf16*)(ws + WS_KV), 2048, (const float*)(ws + WS_RSM), nullptr, (float*)(ws + WS_SSQK), nullptr};
        pg8::gemm_phase<pg8::EpiScale<1>, pg8::StaticOrder, true, true>(lds, g, S, E);
    }
    GRID_SYNC();
    gla_pass_a_all(a, lds, G);
    GRID_SYNC();
    {
        LAS unsigned* qctr = (LAS unsigned*)(lds + 146696);
        if (tid == 0) *qctr = 0u;
        __syncthreads();
        if (wid < 4) gla_scan_w(a, G, tid);
        for (;;) {
            unsigned idx = 0;
            if (lane == 0) idx = __hip_atomic_fetch_add(qctr, 1u, __ATOMIC_RELAXED, __HIP_MEMORY_SCOPE_WORKGROUP);
            idx = (unsigned)__builtin_amdgcn_readfirstlane((int)idx);
            const unsigned pr = (G == 256) ? (unsigned)blockIdx.x * 32u + idx : (unsigned)blockIdx.x + idx * (unsigned)G;
            if ((G == 256 && idx >= 32u) || pr >= 8192u) break;
            sb_pair(a, (int)pr, (LAS bf16*)(lds + wid * 8192), lane);
        }
    }
    GRID_SYNC();
    gla_pass_c_all(a, lds, G);
    GRID_SYNC();
    {
        pg8::Gemm g{R1, (const bf16*)(ws + WS_WOUT), M, D, D}; pg8::StaticOrder S; S.init(M, D, G, (int)blockIdx.x);
        pg8::EpiRes<0> E{a.x, nullptr, nullptr, R2, (float*)(ws + WS_SSQ1)};
        pg8::gemm_phase<pg8::EpiRes<0>, pg8::StaticOrder, true, true>(lds, g, S, E);
    }
    GRID_SYNC();
    {
        pg8::Gemm g{R2, (const bf16*)(ws + WS_WMQ), M, D, D}; pg8::StaticOrder S; S.init(M, D, G, (int)blockIdx.x);
        pg8::EpiScale<2> E{R1, D, (const float*)(ws + WS_SSQ1), a.mq_nw, (float*)(ws + WS_SSQQ), a.mk_nw};
        pg8::gemm_phase<pg8::EpiScale<2>, pg8::StaticOrder, true, true>(lds, g, S, E);
    }
    GRID_SYNC();
    for (int u = blockIdx.x; u < 512; u += G) xattn_unit(a, lds, u);
    GRID_SYNC();
    {
        pg8::Gemm g{(const bf16*)(ws + WS_R3), (const bf16*)(ws + WS_WMO), M, D, D}; pg8::StaticOrder S; S.init(M, D, G, (int)blockIdx.x);
        pg8::EpiRes<1> E{nullptr, R2, nullptr, R1, (float*)(ws + WS_SSQ2)};
        pg8::gemm_phase<pg8::EpiRes<1>, pg8::StaticOrder, true, true>(lds, g, S, E);
    }
    GRID_SYNC();
    {
        pg8::Gemm g{R1, (const bf16*)(ws + WS_WGU), M, 2 * DFF, D}; pg8::StaticOrder S; S.init(M, 2 * DFF, G, (int)blockIdx.x);
        const pg8::RstdTab RT = pg8::fill_rstd_table(S, (const float*)(ws + WS_SSQ2), (LAS float*)(lds + 131072));
        pg8::EpiGateUp E{PROJ, (const float*)(ws + WS_SSQ2), RT};
        pg8::gemm_phase<pg8::EpiGateUp, pg8::StaticOrder, true, true>(lds, g, S, E);
    }
    GRID_SYNC();
    {
        pg8::Gemm g{PROJ, (const bf16*)(ws + WS_WDN), M, D, DFF}; pg8::StaticOrder S; S.init(M, D, G, (int)blockIdx.x);
        pg8::EpiRes<2> E{nullptr, R1, a.out, nullptr, nullptr};
        pg8::gemm_phase<pg8::EpiRes<2>, pg8::StaticOrder, true, true>(lds, g, S, E);
    }
}

extern "C" void kernel_launch(void* const* d_in, const int* in_sizes, int n_in, void* d_out, int out_size, void* d_ws, size_t ws_size, hipStream_t stream) {
    static int grid = 0;
    if (grid == 0) {
        if (n_in != 19 || in_sizes[0] != M * D || out_size != M * D || ws_size < WS_END) { fprintf(stderr, "kernel_launch: unexpected shapes (n_in %d, ws %zu)\n", n_in, ws_size); grid = -1; return; }
        int dev = 0, cus = 0, per_cu = 0;
        if (hipGetDevice(&dev) != hipSuccess || hipDeviceGetAttribute(&cus, hipDeviceAttributeMultiprocessorCount, dev) != hipSuccess) { grid = -1; return; }
        if (hipFuncSetAttribute((const void*)hybrid_fwd, hipFuncAttributeMaxDynamicSharedMemorySize, LDS_BYTES) != hipSuccess) { fprintf(stderr, "kernel_launch: hipFuncSetAttribute failed\n"); grid = -1; return; }
        if (hipOccupancyMaxActiveBlocksPerMultiprocessor(&per_cu, (const void*)hybrid_fwd, NTHR, LDS_BYTES) != hipSuccess || per_cu < 1) { fprintf(stderr, "kernel_launch: occupancy query says %d\n", per_cu); per_cu = 1; }
        (void)hipGetLastError();
        grid = cus;
    }
    if (grid < 0) return;
    if (hipMemsetAsync((char*)d_ws + WS_CTL, 0, 16384, stream) != hipSuccess) { fprintf(stderr, "kernel_launch: memset failed\n"); return; }
    Args a{};
    a.x = (const float*)d_in[0]; a.mem = (const float*)d_in[1]; a.mix_nw = (const float*)d_in[2]; a.w_in = (const float*)d_in[3]; a.w_gk_up = (const float*)d_in[4]; a.b_gk = (const float*)d_in[5];
    a.gla_nw = (const float*)d_in[6]; a.sb_nw = (const float*)d_in[7]; a.w_out = (const float*)d_in[8]; a.xat_nw = (const float*)d_in[9]; a.mem_nw = (const float*)d_in[10]; a.w_mq = (const float*)d_in[11];
    a.w_mkv = (const float*)d_in[12]; a.mq_nw = (const float*)d_in[13]; a.mk_nw = (const float*)d_in[14]; a.w_mo = (const float*)d_in[15]; a.ffn_nw = (const float*)d_in[16]; a.w_gu = (const float*)d_in[17]; a.w_dn = (const float*)d_in[18];
    a.out = (float*)d_out; a.ws = (unsigned char*)d_ws;
    void* args[] = {&a};
    hipError_t e = hipLaunchCooperativeKernel((const void*)hybrid_fwd, dim3(grid), dim3(NTHR), args, LDS_BYTES, stream);
    if (e != hipSuccess) fprintf(stderr, "kernel_launch: cooperative launch failed: %s (grid %d)\n", hipGetErrorString(e), grid);
}
```
